# Optimizing an MI355X kernel written in HIP

```python
import math
import jax
import jax.numpy as jnp
from jax import lax
import numpy as np

D_MODEL = 1024
BATCH = 8
SEQ = 2048
DEPTH = 2
DEC_BATCH = 4
DEC_SEQ = 8192
PAST_LEN = 128

GRID_W = 64
EPS = 1e-6
Q_BLOCK = 128
ROPE_THETA = 500000.0
AXIAL_THETA = 10000.0
NEG = -1e30

A_GROUPS = ((128, 1), (512, 4), (2048, 16))
A_HEADS = 4
A_HEAD_DIM = 96
A_ROT = A_HEAD_DIM // 4
A_QKV = len(A_GROUPS) * A_HEADS * A_HEAD_DIM
A_WIDTH = A_HEADS * A_HEAD_DIM

B_HEADS = 6
B_KV_HEADS = 2
B_HEAD_DIM = 64
B_WIDTH = B_HEADS * B_HEAD_DIM
B_KV = B_KV_HEADS * B_HEAD_DIM

C_HEADS = 4
C_HEAD_DIM = 64
C_WIDTH = C_HEADS * 2 * C_HEAD_DIM
C_ROT = C_HEAD_DIM // 4

IN_SIZES = (A_QKV, A_QKV, A_QKV, A_WIDTH,
            B_WIDTH, B_KV, B_KV, B_WIDTH,
            C_WIDTH, C_WIDTH, C_WIDTH, C_WIDTH)
D_IN = sum(IN_SIZES)
N_BRANCH = 3

kernel_name = 'hybrid_gated_dilated_gqa_diff_encoder'


def rms_norm(x, g):
    xf = x.astype(jnp.float32)
    y = xf * lax.rsqrt(jnp.mean(xf * xf, axis=-1, keepdims=True) + EPS)
    return (y * g.astype(jnp.float32)).astype(x.dtype)


def rope_angles(pos, dim, theta):
    inv = theta ** (-jnp.arange(0, dim, 2, dtype=jnp.float32) / dim)
    return pos.astype(jnp.float32)[:, None] * inv[None, :]


def rotate(x, ang):
    half = x.shape[-1] // 2
    xf = x.astype(jnp.float32)
    x1, x2 = xf[..., :half], xf[..., half:]
    cos = jnp.cos(ang)[None, :, None, :]
    sin = jnp.sin(ang)[None, :, None, :]
    return jnp.concatenate([x1 * cos - x2 * sin, x2 * cos + x1 * sin], axis=-1).astype(x.dtype)


def partial_rope(x, ang):
    n = 2 * ang.shape[-1]
    return jnp.concatenate([rotate(x[..., :n], ang), x[..., n:]], axis=-1)


def axial_rope(x, ang_row, ang_col):
    n = 2 * ang_row.shape[-1]
    return jnp.concatenate([rotate(x[..., :n], ang_row), rotate(x[..., n:2 * n], ang_col)], axis=-1)


def dilated_window_attention(q, k, v, window, dilation):
    Bn, S, H, Dh = q.shape
    R = window // (2 * dilation)
    L = S // dilation
    N = Bn * dilation

    def split(t):
        return t.reshape(Bn, L, dilation, H, Dh).transpose(0, 2, 1, 3, 4).reshape(N, L, H, Dh)

    qs, ks, vs = split(q), split(k), split(v)
    nb = -(-L // R)
    Lp = nb * R
    qs = jnp.pad(qs, ((0, 0), (0, Lp - L), (0, 0), (0, 0)))
    kp = jnp.pad(ks, ((0, 0), (R, Lp - L + R), (0, 0), (0, 0)))
    vp = jnp.pad(vs, ((0, 0), (R, Lp - L + R), (0, 0), (0, 0)))
    qb = qs.reshape(N, nb, R, H, Dh)

    def band(t):
        tb = t.reshape(N, nb + 2, R, H, Dh)
        return jnp.concatenate([tb[:, :-2], tb[:, 1:-1], tb[:, 2:]], axis=2)

    kb, vb = band(kp), band(vp)
    s = jnp.einsum('nbqhd,nbkhd->nbhqk', qb, kb, preferred_element_type=jnp.float32) * (Dh ** -0.5)
    qi = jnp.arange(nb)[:, None] * R + jnp.arange(R)[None, :]
    kj = jnp.arange(nb)[:, None] * R - R + jnp.arange(3 * R)[None, :]
    dist = kj[:, None, :] - qi[:, :, None]
    mask = (jnp.abs(dist) <= R) & (kj[:, None, :] >= 0) & (kj[:, None, :] < L)
    s = jnp.where(mask[None, :, None, :, :], s, NEG)
    m = jnp.max(s, axis=-1, keepdims=True)
    p = jnp.exp(s - m)
    l = jnp.sum(p, axis=-1)
    o = jnp.einsum('nbhqk,nbkhd->nbqhd', p.astype(v.dtype), vb, preferred_element_type=jnp.float32)
    o = o / l.transpose(0, 1, 3, 2)[..., None]
    lse = (m[..., 0] + jnp.log(l)).transpose(0, 1, 3, 2)
    o = o.reshape(N, Lp, H, Dh)[:, :L].reshape(Bn, dilation, L, H, Dh)
    o = o.transpose(0, 2, 1, 3, 4).reshape(Bn, S, H, Dh)
    lse = lse.reshape(N, Lp, H)[:, :L].reshape(Bn, dilation, L, H).transpose(0, 2, 1, 3).reshape(Bn, S, H)
    return o, lse


def dilated_mixture(q, k, v):
    outs, lses = [], []
    for g, (window, dil) in enumerate(A_GROUPS):
        sl = slice(g * A_HEADS, (g + 1) * A_HEADS)
        o, lse = dilated_window_attention(q[:, :, sl], k[:, :, sl], v[:, :, sl], window, dil)
        outs.append(o.astype(jnp.float32))
        lses.append(lse)
    w = jax.nn.softmax(jnp.stack(lses, axis=0), axis=0)
    o = jnp.sum(w[..., None] * jnp.stack(outs, axis=0), axis=0)
    return o.astype(q.dtype)


def gqa_attention(q, k, v):
    Bn, S, Hq, Dh = q.shape
    Hkv = k.shape[2]
    G = Hq // Hkv
    nq = S // Q_BLOCK
    qb = q.reshape(Bn, nq, Q_BLOCK, Hkv, G, Dh).transpose(1, 0, 2, 3, 4, 5)
    scale = Dh ** -0.5

    def block(qi):
        s = jnp.einsum('bqhgd,bkhd->bhgqk', qi, k, preferred_element_type=jnp.float32) * scale
        p = jax.nn.softmax(s, axis=-1).astype(v.dtype)
        return jnp.einsum('bhgqk,bkhd->bqhgd', p, v, preferred_element_type=jnp.float32).astype(v.dtype)

    o = lax.map(block, qb)
    return o.transpose(1, 0, 2, 3, 4, 5).reshape(Bn, S, Hq, Dh)


def diff_attention(q1, q2, k1, k2, v, lam):
    Bn, S, H, Dh = q1.shape
    nq = S // Q_BLOCK
    scale = Dh ** -0.5

    def blk(t):
        return t.reshape(Bn, nq, Q_BLOCK, H, Dh).transpose(1, 0, 2, 3, 4)

    def block(args):
        a, b = args
        s1 = jnp.einsum('bqhd,bkhd->bhqk', a, k1, preferred_element_type=jnp.float32) * scale
        s2 = jnp.einsum('bqhd,bkhd->bhqk', b, k2, preferred_element_type=jnp.float32) * scale
        w = jax.nn.softmax(s1, axis=-1) - lam * jax.nn.softmax(s2, axis=-1)
        return jnp.einsum('bhqk,bkhe->bqhe', w.astype(v.dtype), v, preferred_element_type=jnp.float32).astype(v.dtype)

    o = lax.map(block, (blk(q1), blk(q2)))
    return o.transpose(1, 0, 2, 3, 4).reshape(Bn, S, H, v.shape[-1])


def encoder_layer(x, c, ang_a, ang_row, ang_col, ang_c, lam_init,
                  norm_g, w_ada, b_ada, w_in, qn_a, kn_a, qn_b, kn_b, qn_c, kn_c,
                  lam_q1, lam_k1, lam_q2, lam_k2, subln_c, w_oa, w_ob, w_oc, w_bg, b_bg, w_out):
    Bn, S, _ = x.shape
    mod = jnp.einsum('bd,de->be', jax.nn.silu(c), w_ada) + b_ada
    shift, scale, gate = jnp.split(mod, 3, axis=-1)
    h = rms_norm(x, norm_g) * (1 + scale[:, None, :]) + shift[:, None, :]

    u = jnp.einsum('bsd,de->bse', h, w_in)
    offs = []
    acc = 0
    for n in IN_SIZES[:-1]:
        acc += n
        offs.append(acc)
    qa, ka, va, za, qb, kb, vb, zb, qc, kc, vc, zc = jnp.split(u, offs, axis=-1)

    n_a = len(A_GROUPS) * A_HEADS
    qa = partial_rope(rms_norm(qa.reshape(Bn, S, n_a, A_HEAD_DIM), qn_a), ang_a)
    ka = partial_rope(rms_norm(ka.reshape(Bn, S, n_a, A_HEAD_DIM), kn_a), ang_a)
    va = va.reshape(Bn, S, n_a, A_HEAD_DIM)
    ya = dilated_mixture(qa, ka, va).reshape(Bn, S, A_WIDTH)

    qb = axial_rope(rms_norm(qb.reshape(Bn, S, B_HEADS, B_HEAD_DIM), qn_b), ang_row, ang_col)
    kb = axial_rope(rms_norm(kb.reshape(Bn, S, B_KV_HEADS, B_HEAD_DIM), kn_b), ang_row, ang_col)
    yb = gqa_attention(qb, kb, vb.reshape(Bn, S, B_KV_HEADS, B_HEAD_DIM)).reshape(Bn, S, B_WIDTH)

    qc = partial_rope(rms_norm(qc.reshape(Bn, S, 2 * C_HEADS, C_HEAD_DIM), qn_c), ang_c)
    kc = partial_rope(rms_norm(kc.reshape(Bn, S, 2 * C_HEADS, C_HEAD_DIM), kn_c), ang_c)
    f32 = jnp.float32
    lam = (jnp.exp(jnp.sum(lam_q1.astype(f32) * lam_k1.astype(f32)))
           - jnp.exp(jnp.sum(lam_q2.astype(f32) * lam_k2.astype(f32))) + lam_init)
    oc = diff_attention(qc[:, :, 0::2], qc[:, :, 1::2], kc[:, :, 0::2], kc[:, :, 1::2],
                        vc.reshape(Bn, S, C_HEADS, 2 * C_HEAD_DIM), lam)
    yc = (rms_norm(oc, subln_c) * (1.0 - lam_init)).reshape(Bn, S, C_WIDTH)

    pa = jnp.einsum('bse,ed->bsd', ya * jax.nn.silu(za), w_oa)
    pb = jnp.einsum('bse,ed->bsd', yb * jax.nn.silu(zb), w_ob)
    pc = jnp.einsum('bse,ed->bsd', yc * jax.nn.silu(zc), w_oc)

    g = jax.nn.sigmoid(jnp.einsum('bsd,de->bse', h, w_bg) + b_bg)
    ga, gb, gc = jnp.split(g, N_BRANCH, axis=-1)
    merged = ga * pa + gb * pb + gc * pc
    out = jnp.einsum('bsd,de->bse', merged, w_out)
    return x + gate[:, None, :] * out


def trunk(x, c, layer_params):
    S = x.shape[1]
    rows = S // GRID_W
    pos = jnp.arange(S)
    row = jnp.repeat(jnp.arange(rows), GRID_W)
    col = jnp.tile(jnp.arange(GRID_W), rows)
    ang_a = rope_angles(pos, A_ROT, ROPE_THETA)
    ang_c = rope_angles(pos, C_ROT, ROPE_THETA)
    ang_row = rope_angles(row, B_HEAD_DIM // 2, AXIAL_THETA)
    ang_col = rope_angles(col, B_HEAD_DIM // 2, AXIAL_THETA)
    for l in range(DEPTH):
        lam_init = 0.8 - 0.6 * math.exp(-0.3 * l)
        x = encoder_layer(x, c, ang_a, ang_row, ang_col, ang_c, lam_init,
                          *[p[l] for p in layer_params])
    return x


def setup_inputs(seed: int = 0) -> dict:
    key = jax.random.key(seed)
    ks = jax.random.split(key, 26)
    f32 = jnp.float32

    def nrm(k, shape, s):
        return jax.random.normal(k, shape, f32) * s

    D = D_MODEL
    return {
        'x_prompt': nrm(ks[0], (BATCH, SEQ, D), 1.0),
        'x_sample': nrm(ks[1], (DEC_BATCH, DEC_SEQ, D), 1.0),
        'c_prompt': nrm(ks[2], (BATCH, D), 1.0),
        'c_sample': nrm(ks[3], (DEC_BATCH, D), 1.0),
        'norm_g': 1.0 + nrm(ks[4], (DEPTH, D), 0.05),
        'w_ada': nrm(ks[5], (DEPTH, D, 3 * D), D ** -0.5),
        'b_ada': nrm(ks[6], (DEPTH, 3 * D), 0.02),
        'w_in': nrm(ks[7], (DEPTH, D, D_IN), D ** -0.5),
        'qn_a': 1.0 + nrm(ks[8], (DEPTH, A_HEAD_DIM), 0.05),
        'kn_a': 1.0 + nrm(ks[9], (DEPTH, A_HEAD_DIM), 0.05),
        'qn_b': 1.0 + nrm(ks[10], (DEPTH, B_HEAD_DIM), 0.05),
        'kn_b': 1.0 + nrm(ks[11], (DEPTH, B_HEAD_DIM), 0.05),
        'qn_c': 1.0 + nrm(ks[12], (DEPTH, C_HEAD_DIM), 0.05),
        'kn_c': 1.0 + nrm(ks[13], (DEPTH, C_HEAD_DIM), 0.05),
        'lam_q1': nrm(ks[14], (DEPTH, C_HEAD_DIM), 0.1),
        'lam_k1': nrm(ks[15], (DEPTH, C_HEAD_DIM), 0.1),
        'lam_q2': nrm(ks[16], (DEPTH, C_HEAD_DIM), 0.1),
        'lam_k2': nrm(ks[17], (DEPTH, C_HEAD_DIM), 0.1),
        'subln_c': 1.0 + nrm(ks[18], (DEPTH, 2 * C_HEAD_DIM), 0.05),
        'w_oa': nrm(ks[19], (DEPTH, A_WIDTH, D), A_WIDTH ** -0.5),
        'w_ob': nrm(ks[20], (DEPTH, B_WIDTH, D), B_WIDTH ** -0.5),
        'w_oc': nrm(ks[21], (DEPTH, C_WIDTH, D), C_WIDTH ** -0.5),
        'w_bg': nrm(ks[22], (DEPTH, D, N_BRANCH * D), D ** -0.5),
        'b_bg': nrm(ks[23], (DEPTH, N_BRANCH * D), 0.02),
        'w_out': nrm(ks[24], (DEPTH, D, D), D ** -0.5),
    }


def reference(x_prompt, x_sample, c_prompt, c_sample, norm_g, w_ada, b_ada, w_in,
              qn_a, kn_a, qn_b, kn_b, qn_c, kn_c, lam_q1, lam_k1, lam_q2, lam_k2, subln_c,
              w_oa, w_ob, w_oc, w_bg, b_bg, w_out):
    layer_params = (norm_g, w_ada, b_ada, w_in, qn_a, kn_a, qn_b, kn_b, qn_c, kn_c,
                    lam_q1, lam_k1, lam_q2, lam_k2, subln_c, w_oa, w_ob, w_oc, w_bg, b_bg, w_out)
    y_prompt = trunk(x_prompt, c_prompt, layer_params)
    y_sample = trunk(x_sample, c_sample, layer_params)
    return (y_prompt, y_sample)
```

```cpp
#include <hip/hip_runtime.h>
#include <hip/hip_cooperative_groups.h>
#include <cstdint>
#include <cstdio>
#include <cmath>
namespace cg = cooperative_groups;

#define LAS __attribute__((address_space(3)))
#define GAS __attribute__((address_space(1)))
typedef unsigned short bf16_t;
typedef short bf16x8 __attribute__((ext_vector_type(8)));
typedef short s16x4 __attribute__((ext_vector_type(4)));
typedef float f32x4 __attribute__((ext_vector_type(4)));
typedef float f32x16 __attribute__((ext_vector_type(16)));
typedef unsigned u32x4 __attribute__((ext_vector_type(4)));
typedef unsigned u32x2 __attribute__((ext_vector_type(2)));

constexpr int DM = 1024, TTOK = 49152, CH = 16384, NCHUNK = 3, NSEQ = 12;
constexpr int LDU = 9984;
constexpr int PO = 1408;
constexpr int LDY = 1280;
constexpr float EPS = 1e-6f;
constexpr float LOG2E = 1.4426950408889634f;
constexpr float C2_64 = 0.125f * LOG2E;
constexpr float C2_96 = 0.10206207261596577f * LOG2E;
constexpr int O_QA = 0, O_KA = 1152, O_VA = 2304, O_ZA = 3456, O_QB = 3840, O_KB = 4224, O_VB = 4352, O_ZB = 4480,
              O_QC = 4864, O_KC = 5376, O_VC = 5888, O_ZC = 6400, O_G = 6912;
constexpr size_t MiB = 1u << 20;
constexpr size_t WS_MOD = 0;
constexpr size_t WS_BAR = 576 * 1024;
constexpr size_t WS_SC = 512 * 1024;
constexpr size_t WS_TAB = 1 * MiB;
constexpr size_t WS_WIN = 8 * MiB;
constexpr size_t WS_WO = 48 * MiB;
constexpr size_t WS_WOUT = 54 * MiB;
constexpr size_t WS_H = 60 * MiB;
constexpr size_t WS_LA = 92 * MiB;
constexpr size_t WS_VAT = 94 * MiB;
constexpr size_t WS_OB = 134 * MiB;
constexpr size_t WS_U = 178 * MiB;
constexpr size_t WS_END = 490 * MiB;
constexpr int RING_BYTES = 131072, LDS_BYTES = RING_BYTES + 1024;

#ifndef PH
#define PH 0xFFF
#endif
#ifndef DUP
#define DUP 0
#endif
#define GSYNC() do { xcd_barrier(xbar); if (DUP & 256) xcd_barrier(xbar); } while (0)
struct Params { const float* in[25]; float* out; unsigned char* ws; double inv[36]; };

__device__ __forceinline__ unsigned f2bf(float f) { unsigned u = __builtin_bit_cast(unsigned, f); return (u + 0x7fffu + ((u >> 16) & 1u)) >> 16; }
__device__ __forceinline__ unsigned pk2(float lo, float hi) { return f2bf(lo) | (f2bf(hi) << 16); }
__device__ __forceinline__ float bflo(unsigned w) { return __builtin_bit_cast(float, w << 16); }
__device__ __forceinline__ float bfhi(unsigned w) { return __builtin_bit_cast(float, w & 0xffff0000u); }
__device__ __forceinline__ float sigmoidf_(float v) { return __builtin_amdgcn_rcpf(1.0f + __builtin_amdgcn_exp2f(-v * LOG2E)); }
__device__ __forceinline__ int opq_tid() { int t = threadIdx.x; asm volatile("" : "+v"(t)); return t; }
template <int X> __device__ __forceinline__ float shx(float v) {
    if constexpr (X < 32) return __builtin_bit_cast(float, __builtin_amdgcn_ds_swizzle(__builtin_bit_cast(int, v), (X << 10) | 0x1F));
    else return __builtin_bit_cast(float, __builtin_amdgcn_ds_bpermute((((opq_tid() & 63) ^ X) << 2), __builtin_bit_cast(int, v)));
}
__device__ __forceinline__ float sum16(float v) { v += shx<1>(v); v += shx<2>(v); v += shx<4>(v); v += shx<8>(v); return v; }
__device__ __forceinline__ float wave_sum(float v) { v = sum16(v); v += shx<16>(v); v += shx<32>(v); return v; }
__device__ __forceinline__ float wave_max(float v) { v = fmaxf(v, shx<1>(v)); v = fmaxf(v, shx<2>(v)); v = fmaxf(v, shx<4>(v)); v = fmaxf(v, shx<8>(v)); v = fmaxf(v, shx<16>(v)); v = fmaxf(v, shx<32>(v)); return v; }
#define LDS_WAIT() asm volatile("s_waitcnt lgkmcnt(0)" ::: "memory")
template <class T> __device__ __forceinline__ T* opq(T* p) { asm volatile("" : "+s"(p)); return (T*)(__attribute__((address_space(1))) T*)p; }

namespace pg8 {
constexpr int BM = 256, BK = 64, HALF = 128, HTB = HALF * BK * 2, STAGE_BYTES = 8 * HTB, NXCD = 8, WGM = 4;
__device__ __forceinline__ int lds_byte(int r, int c) { const int st = (r >> 4) * 2 + (c >> 5), rr = r & 15, cc = c & 31, ob = rr * 64 + cc * 2; return st * 1024 + (ob ^ (((ob >> 9) & 1) << 5)); }
__device__ __forceinline__ void stage_rc(int b, int& R, int& C) { const int st = b / 1024, sb = b % 1024, swz = sb ^ (((sb >> 9) & 1) << 5); R = (st >> 1) * 16 + swz / 64; C = (st & 1) * 32 + (swz % 64) / 2; }
__device__ __forceinline__ int perm32(int rho) { const int n = rho >> 4, i = rho & 15; return 8 * (i >> 2) + 4 * n + (i & 3); }
struct Unit { int pm, pn; };
struct Gemm { const bf16_t* A; const bf16_t* Bt; int M, N, K, lda, ldb; };
struct StaticOrder {
    int nM, nN, nwg, G, c;
    __device__ void init(int M, int N, int G_, int c_) { nM = M / BM; nN = N / BM; nwg = nM * nN; G = G_; c = c_; }
    __device__ bool next(int i, Unit& u) const {
        const long L = (long)i * G + c; if (L >= nwg) return false;
        int wgid = (int)L; { const int q = nwg / NXCD, r = nwg % NXCD, xcd = wgid % NXCD, off = wgid / NXCD; wgid = (xcd < r ? xcd * (q + 1) : r * (q + 1) + (xcd - r) * q) + off; }
        const int nig = WGM * nN, gid = wgid / nig, fm = gid * WGM, gsz = (nM - fm) < WGM ? (nM - fm) : WGM;
        u.pm = fm + ((wgid % nig) % gsz); u.pn = (wgid % nig) / gsz; return true;
    }
};
__device__ __forceinline__ unsigned cvt_pk_bf16(float lo, float hi) { unsigned r; asm volatile("v_cvt_pk_bf16_f32 %0, %1, %2" : "=v"(r) : "v"(lo), "v"(hi)); return r; }

template <class Epi, bool ALIGN_EPI>
__device__ __forceinline__ void gemm_phase(LAS unsigned char* lds, const Gemm g, const StaticOrder& S, const Epi& E) {
    const int tid = opq_tid(), wid = __builtin_amdgcn_readfirstlane(tid >> 6), lane = tid & 63, wr = wid >> 2, wc = wid & 3, fr = lane & 15, fq = lane >> 4;
    const int K = g.K, nt = K / BK;
    unsigned voffA[2], voffB[2];
#pragma unroll
    for (int i = 0; i < 2; ++i) { int R, C; stage_rc(tid * 16 + i * 8192, R, C); const int Rb = Epi::PERM ? ((R & ~31) + perm32(R & 31)) : R;
        voffA[i] = (unsigned)(R * g.lda + C) * 2u; voffB[i] = (unsigned)(Rb * g.ldb + C) * 2u; }
    const size_t kstep = (size_t)(BK * 2);
    const size_t hstepA = (size_t)HALF * g.lda * 2, hstepB = (size_t)HALF * g.ldb * 2;
    const size_t tstepA = 2 * hstepA, tstepB = 2 * hstepB;
    const unsigned ldsw = (unsigned)wid * 1024u;
    const int aoff = lds_byte(wr * 64 + fr, fq * 8), boff = lds_byte(wc * 32 + fr, fq * 8);
#define PG8_SA(b, h) (((b) * 2 + (h)) * HTB)
#define PG8_SB(b, h) ((4 + (b) * 2 + (h)) * HTB)
#define PG8_STAGE(bufoff, gbase, voff) do { _Pragma("unroll") for (int _i = 0; _i < 2; ++_i) \
        __builtin_amdgcn_global_load_lds((const unsigned*)((const char*)(gbase) + (voff)[_i]), (LAS unsigned*)(lds + (bufoff) + ldsw + _i * 8192), 16, 0, 0); } while (0)
#define PG8_LDA(dst, b, h) do { _Pragma("unroll") for (int m = 0; m < 4; ++m) _Pragma("unroll") for (int k = 0; k < 2; ++k) dst[m][k] = *(const LAS bf16x8*)(lds + PG8_SA(b, h) + aoff + m * 2048 + k * 1024); } while (0)
#define PG8_LDB(dst, b, h) do { _Pragma("unroll") for (int n = 0; n < 2; ++n) _Pragma("unroll") for (int k = 0; k < 2; ++k) dst[n][k] = *(const LAS bf16x8*)(lds + PG8_SB(b, h) + boff + n * 2048 + k * 1024); } while (0)
#define PG8_MMA(ai, bj, At, Bt) do { __builtin_amdgcn_s_setprio(1); _Pragma("unroll") for (int m = 0; m < 4; ++m) _Pragma("unroll") for (int n = 0; n < 2; ++n) _Pragma("unroll") for (int k = 0; k < 2; ++k) \
        acc[ai][bj][m][n] = __builtin_amdgcn_mfma_f32_16x16x32_bf16(Bt[n][k], At[m][k], acc[ai][bj][m][n], 0, 0, 0); __builtin_amdgcn_s_setprio(0); } while (0)
#define PG8_WAIT_V(n) asm volatile("s_waitcnt vmcnt(" #n ")" ::: "memory")
#define PG8_WAIT_L(n) asm volatile("s_waitcnt lgkmcnt(" #n ")" ::: "memory")
#define PG8_BAR __builtin_amdgcn_s_barrier()
#define PG8_SCHED __builtin_amdgcn_sched_barrier(0)
    Unit cur, nxt; int ui = 0;
    if (!S.next(0, cur)) return;
    f32x4 acc[2][2][4][2];
#pragma unroll
    for (int a = 0; a < 2; ++a)
#pragma unroll
        for (int b = 0; b < 2; ++b)
#pragma unroll
            for (int m = 0; m < 4; ++m)
#pragma unroll
                for (int n = 0; n < 2; ++n) acc[a][b][m][n] = (f32x4){0.f, 0.f, 0.f, 0.f};
    bf16x8 At[4][2], B0[2][2], B1[2][2];
    const char* cA = (const char*)g.A + (size_t)cur.pm * tstepA; const char* cB = (const char*)g.Bt + (size_t)cur.pn * tstepB;
    PG8_STAGE(PG8_SB(0, 0), cB, voffB); PG8_STAGE(PG8_SB(0, 1), cB + hstepB, voffB); PG8_STAGE(PG8_SA(0, 0), cA, voffA); PG8_STAGE(PG8_SA(0, 1), cA + hstepA, voffA);
    if (wr == 1) PG8_BAR;
    PG8_WAIT_V(2); PG8_BAR;
    PG8_STAGE(PG8_SB(1, 0), cB + kstep, voffB); PG8_STAGE(PG8_SA(1, 0), cA + kstep, voffA); PG8_STAGE(PG8_SB(1, 1), cB + hstepB + kstep, voffB);
    PG8_WAIT_V(6); PG8_BAR;
    for (;;) {
        const bool has_next = S.next(ui + 1, nxt);
        const char* nA = has_next ? (const char*)g.A + (size_t)nxt.pm * tstepA : cA; const char* nB = has_next ? (const char*)g.Bt + (size_t)nxt.pn * tstepB : cB;
#pragma unroll 1
        for (int t = 0; t < nt; t += 2) {
            const bool last = (t == nt - 2);
            const char* a1 = cA + (size_t)(t + 1) * kstep;
            const char* a2 = last ? nA : cA + (size_t)(t + 2) * kstep; const char* b2 = last ? nB : cB + (size_t)(t + 2) * kstep;
            const char* a3 = a2 + kstep; const char* b3 = b2 + kstep;
            PG8_LDB(B0, 0, 0); PG8_LDB(B1, 0, 1); PG8_SCHED; PG8_LDA(At, 0, 0); PG8_STAGE(PG8_SA(1, 1), a1 + hstepA, voffA);
            PG8_WAIT_V(8); PG8_WAIT_L(0); PG8_BAR; PG8_MMA(0, 0, At, B0); PG8_MMA(0, 1, At, B1); PG8_BAR; PG8_SCHED;
            PG8_LDA(At, 0, 1); PG8_STAGE(PG8_SB(0, 0), b2, voffB); PG8_STAGE(PG8_SB(0, 1), b2 + hstepB, voffB); PG8_STAGE(PG8_SA(0, 0), a2, voffA);
            PG8_WAIT_V(8); PG8_WAIT_L(0); PG8_BAR; PG8_MMA(1, 0, At, B0); PG8_MMA(1, 1, At, B1); PG8_BAR; PG8_SCHED;
            PG8_LDB(B0, 1, 0); PG8_LDB(B1, 1, 1); PG8_SCHED; PG8_LDA(At, 1, 0); PG8_STAGE(PG8_SA(0, 1), a2 + hstepA, voffA);
            PG8_WAIT_V(8); PG8_WAIT_L(0); PG8_BAR; PG8_MMA(0, 0, At, B0); PG8_MMA(0, 1, At, B1); PG8_BAR; PG8_SCHED;
            PG8_LDA(At, 1, 1); PG8_STAGE(PG8_SB(1, 0), b3, voffB); PG8_STAGE(PG8_SB(1, 1), b3 + hstepB, voffB); PG8_STAGE(PG8_SA(1, 0), a3, voffA);
            PG8_WAIT_V(8); PG8_WAIT_L(0); PG8_BAR; PG8_MMA(1, 0, At, B0); PG8_MMA(1, 1, At, B1); PG8_BAR; PG8_SCHED;
        }
        if constexpr (ALIGN_EPI) { if (wr == 0) PG8_BAR; }
        E(acc, cur, wr, wc, fr, fq);
        if (!has_next) break;
#pragma unroll
        for (int a = 0; a < 2; ++a)
#pragma unroll
            for (int b = 0; b < 2; ++b)
#pragma unroll
                for (int m = 0; m < 4; ++m)
#pragma unroll
                    for (int n = 0; n < 2; ++n) acc[a][b][m][n] = (f32x4){0.f, 0.f, 0.f, 0.f};
        cur = nxt; cA = nA; cB = nB; ++ui;
        if constexpr (ALIGN_EPI) { if (wr == 1) PG8_BAR; }
    }
    PG8_WAIT_V(0);
    if constexpr (!ALIGN_EPI) { if (wr == 0) PG8_BAR; }
    PG8_BAR;
#undef PG8_SA
#undef PG8_SB
#undef PG8_STAGE
#undef PG8_LDA
#undef PG8_LDB
#undef PG8_MMA
#undef PG8_WAIT_V
#undef PG8_WAIT_L
#undef PG8_BAR
#undef PG8_SCHED
}

struct EpiU {
    static constexpr bool PERM = true;
    bf16_t* U; const float* bbg;
    __device__ __forceinline__ void operator()(const f32x4 (&acc)[2][2][4][2], const Unit& u, int wr, int wc, int fr, int fq) const {
        const int row0 = u.pm * BM + wr * 64 + fr, colt = u.pn * BM;
        int mode[2]; f32x4 bv[2][2];
#pragma unroll
        for (int bj = 0; bj < 2; ++bj) { const int c0 = colt + bj * HALF + wc * 32 + 8 * fq;
            mode[bj] = (c0 >= O_G) ? 2 : (((c0 >= O_ZA && c0 < O_QB) || (c0 >= O_ZB && c0 < O_QC) || (c0 >= O_ZC)) ? 1 : 0);
            const int cb = (c0 >= O_G) ? (c0 - O_G) : 0;
            bv[bj][0] = *(const f32x4*)(bbg + cb); bv[bj][1] = *(const f32x4*)(bbg + cb + 4);
            if (mode[bj] != 2) { bv[bj][0] = (f32x4){0.f, 0.f, 0.f, 0.f}; bv[bj][1] = bv[bj][0]; } }
#pragma unroll
        for (int ai = 0; ai < 2; ++ai)
#pragma unroll
            for (int m = 0; m < 4; ++m) { bf16_t* rowp = U + (size_t)(row0 + ai * HALF + m * 16) * LDU + colt + wc * 32 + 8 * fq;
#pragma unroll
                for (int bj = 0; bj < 2; ++bj) { f32x4 v0 = acc[ai][bj][m][0] + bv[bj][0], v1 = acc[ai][bj][m][1] + bv[bj][1];
                    if (mode[bj] != 0) {
                        const bool z = (mode[bj] == 1);
#pragma unroll
                        for (int e = 0; e < 4; ++e) { const float s0 = sigmoidf_(v0[e]), s1 = sigmoidf_(v1[e]); v0[e] = z ? v0[e] * s0 : s0; v1[e] = z ? v1[e] * s1 : s1; }
                    }
                    u32x4 w; w.x = cvt_pk_bf16(v0[0], v0[1]); w.y = cvt_pk_bf16(v0[2], v0[3]); w.z = cvt_pk_bf16(v1[0], v1[1]); w.w = cvt_pk_bf16(v1[2], v1[3]);
                    *(u32x4*)(rowp + bj * HALF) = w; } }
    }
};
struct EpiMerge {
    static constexpr bool PERM = true;
    const bf16_t* G; bf16_t* Mg; int accum;
    __device__ __forceinline__ void operator()(const f32x4 (&acc)[2][2][4][2], const Unit& u, int wr, int wc, int fr, int fq) const {
        const int row0 = u.pm * BM + wr * 64 + fr, col0 = u.pn * BM + wc * 32 + 8 * fq;
        const bf16_t* gp = G + (size_t)row0 * LDU + col0; bf16_t* mp = Mg + (size_t)row0 * DM + col0;
#pragma unroll
        for (int ai = 0; ai < 2; ++ai) {
            u32x4 gw[4][2], ow[4][2];
#pragma unroll
            for (int m = 0; m < 4; ++m)
#pragma unroll
                for (int bj = 0; bj < 2; ++bj) { gw[m][bj] = *(const GAS u32x4*)(gp + (size_t)m * 16 * LDU + bj * HALF);
                    ow[m][bj] = accum ? *(const GAS u32x4*)(mp + (size_t)m * 16 * DM + bj * HALF) : (u32x4){0u, 0u, 0u, 0u}; }
            __builtin_amdgcn_sched_barrier(0);
#pragma unroll
            for (int m = 0; m < 4; ++m)
#pragma unroll
                for (int bj = 0; bj < 2; ++bj) {
                    f32x4 v0 = acc[ai][bj][m][0], v1 = acc[ai][bj][m][1]; const u32x4 g4 = gw[m][bj], o4 = ow[m][bj];
                    v0[0] = v0[0] * bflo(g4.x) + bflo(o4.x); v0[1] = v0[1] * bfhi(g4.x) + bfhi(o4.x); v0[2] = v0[2] * bflo(g4.y) + bflo(o4.y); v0[3] = v0[3] * bfhi(g4.y) + bfhi(o4.y);
                    v1[0] = v1[0] * bflo(g4.z) + bflo(o4.z); v1[1] = v1[1] * bfhi(g4.z) + bfhi(o4.z); v1[2] = v1[2] * bflo(g4.w) + bflo(o4.w); v1[3] = v1[3] * bfhi(g4.w) + bfhi(o4.w);
                    u32x4 w; w.x = cvt_pk_bf16(v0[0], v0[1]); w.y = cvt_pk_bf16(v0[2], v0[3]); w.z = cvt_pk_bf16(v1[0], v1[1]); w.w = cvt_pk_bf16(v1[2], v1[3]);
                    *(GAS u32x4*)(mp + (size_t)m * 16 * DM + bj * HALF) = w; }
            gp += 128 * LDU; mp += 128 * DM;
            asm volatile("" : "+v"(gp), "+v"(mp) :: "memory"); }
    }
};
struct EpiOut {
    static constexpr bool PERM = false;
    const float* xin; float* out; const float* modl; int chunk;
    __device__ __forceinline__ void operator()(const f32x4 (&acc)[2][2][4][2], const Unit& u, int wr, int wc, int fr, int fq) const {
        const int rowt = u.pm * BM; const int s = (chunk == 0) ? (rowt >> 11) : (8 + 2 * (chunk - 1) + (rowt >> 13));
        const float* gp = modl + (size_t)s * 3072 + 2048;
        const int row0 = rowt + wr * 64 + fr, col0 = u.pn * BM + wc * 32 + 4 * fq;
        f32x4 gv[2][2];
#pragma unroll
        for (int bj = 0; bj < 2; ++bj)
#pragma unroll
            for (int n = 0; n < 2; ++n) gv[bj][n] = *(const f32x4*)(gp + col0 + bj * HALF + n * 16);
#pragma unroll
        for (int ai = 0; ai < 2; ++ai) {
            f32x4 xb[4][2][2];
#pragma unroll
            for (int m = 0; m < 4; ++m) { const size_t off = (size_t)(row0 + ai * HALF + m * 16) * DM + col0;
#pragma unroll
                for (int bj = 0; bj < 2; ++bj)
#pragma unroll
                    for (int n = 0; n < 2; ++n) xb[m][bj][n] = *(const GAS f32x4*)(xin + off + bj * HALF + n * 16); }
            __builtin_amdgcn_sched_barrier(0);
#pragma unroll
            for (int m = 0; m < 4; ++m) { const size_t off = (size_t)(row0 + ai * HALF + m * 16) * DM + col0;
#pragma unroll
                for (int bj = 0; bj < 2; ++bj)
#pragma unroll
                    for (int n = 0; n < 2; ++n) *(GAS f32x4*)(out + off + bj * HALF + n * 16) = xb[m][bj][n] + gv[bj][n] * acc[ai][bj][m][n]; }
            __builtin_amdgcn_sched_barrier(0); }
    }
};
}

namespace attn_body {
constexpr int D = 64, NW = 8, QBLK = 32, QB = QBLK * NW, KVBLK = 64;
constexpr int PU = LDU;
__device__ __forceinline__ int crow(int r, int hi) { return (r & 3) + 8 * (r >> 2) + 4 * hi; }
#define SBAR() __builtin_amdgcn_sched_barrier(0)
constexpr int NSLOT = 3, SLOTB = 8192;
constexpr int LDS_K = 0, LDS_V = NSLOT * SLOTB, LDS_WS = 2 * NSLOT * SLOTB, LDS_OST = LDS_WS + NW * 64 * 4, LDS_BYTES_A = LDS_OST + NW * 4096;
__device__ __forceinline__ void glds16(const void* gsrc, unsigned lds_dst) { unsigned keep;
  asm volatile("s_mov_b32 %0, m0\n\ts_mov_b32 m0, %2\n\ts_nop 0\n\tglobal_load_lds_dwordx4 %1, off\n\ts_mov_b32 m0, %0" : "=&s"(keep) : "v"(gsrc), "s"(lds_dst) : "memory"); }
__device__ __forceinline__ float max3f(float a, float b, float c) { float r; asm("v_max3_f32 %0, %1, %2, %3" : "=v"(r) : "v"(a), "v"(b), "v"(c)); return r; }
__device__ __forceinline__ float max2f(float a, float b) { float r; asm("v_max_f32_e32 %0, %1, %2" : "=v"(r) : "v"(a), "v"(b)); return r; }
__device__ __forceinline__ float fadd_s(float a, float b) { float r; asm("v_add_f32_e32 %0, %1, %2" : "=v"(r) : "v"(a), "v"(b)); return r; }
__device__ __forceinline__ float fsub_s(float a, float b) { float r; asm("v_sub_f32_e32 %0, %1, %2" : "=v"(r) : "v"(a), "v"(b)); return r; }
typedef float f32x2_t __attribute__((ext_vector_type(2))); typedef __bf16 bf16x2_t __attribute__((ext_vector_type(2)));
__device__ __forceinline__ unsigned cvtpk_s(float lo, float hi) { f32x2_t v = {lo, hi}; bf16x2_t b = __builtin_convertvector(v, bf16x2_t); return __builtin_bit_cast(unsigned, b); }
#define WAIT_BAR(N) asm volatile("s_waitcnt vmcnt(" #N ") lgkmcnt(0)\n\ts_barrier" ::: "memory")
__device__ __forceinline__ void qkt(f32x16& p0, f32x16& p1, const char* Kslot, const bf16x8* qr, const f32x16& negm, int r32, int hi) {
  const char* kb = Kslot + hi * 1024 + r32 * 16;
  #pragma unroll
  for (int d0 = 0; d0 < 4; ++d0) {
    const bf16x8 b0 = *reinterpret_cast<const bf16x8*>(kb + d0 * 2048);
    const bf16x8 b1 = *reinterpret_cast<const bf16x8*>(kb + d0 * 2048 + 512);
    if (d0 == 0) { p0 = __builtin_amdgcn_mfma_f32_32x32x16_bf16(b0, qr[0], negm, 0, 0, 0); p1 = __builtin_amdgcn_mfma_f32_32x32x16_bf16(b1, qr[0], negm, 0, 0, 0); }
    else { p0 = __builtin_amdgcn_mfma_f32_32x32x16_bf16(b0, qr[d0], p0, 0, 0, 0); p1 = __builtin_amdgcn_mfma_f32_32x32x16_bf16(b1, qr[d0], p1, 0, 0, 0); } }
}
typedef __attribute__((address_space(3))) const char* lds_cptr;
typedef short v4i16_t __attribute__((ext_vector_type(4)));
__device__ __forceinline__ void kload8(bf16x8* kf, lds_cptr kp) {
  kf[0] = *(const __attribute__((address_space(3))) bf16x8*)(kp);        kf[1] = *(const __attribute__((address_space(3))) bf16x8*)(kp + 512);
  kf[2] = *(const __attribute__((address_space(3))) bf16x8*)(kp + 2048); kf[3] = *(const __attribute__((address_space(3))) bf16x8*)(kp + 2560);
  kf[4] = *(const __attribute__((address_space(3))) bf16x8*)(kp + 4096); kf[5] = *(const __attribute__((address_space(3))) bf16x8*)(kp + 4608);
  kf[6] = *(const __attribute__((address_space(3))) bf16x8*)(kp + 6144); kf[7] = *(const __attribute__((address_space(3))) bf16x8*)(kp + 6656);
}
__device__ __forceinline__ void kload2(bf16x8* kf, lds_cptr kp, int j) { kf[2 * j] = *(const __attribute__((address_space(3))) bf16x8*)(kp + j * 2048); kf[2 * j + 1] = *(const __attribute__((address_space(3))) bf16x8*)(kp + j * 2048 + 512); }
__device__ __forceinline__ s16x4 vtr(lds_cptr p) { return __builtin_bit_cast(s16x4, __builtin_amdgcn_ds_read_tr16_b64_v4i16((__attribute__((address_space(3))) v4i16_t*)p)); }
__device__ __forceinline__ float rowmax(const f32x16& p0, const f32x16& p1) {
  float a = max3f(p0[0], p0[1], p1[0]), b = max3f(p0[2], p0[3], p1[1]); a = max3f(a, p1[2], p1[3]);
  #pragma unroll
  for (int r = 4; r < 16; r += 4) { a = max3f(a, p0[r], p0[r + 1]); b = max3f(b, p0[r + 2], p0[r + 3]); a = max3f(a, p1[r], p1[r + 1]); b = max3f(b, p1[r + 2], p1[r + 3]); }
  const float m = max2f(a, b);
  auto rr = __builtin_amdgcn_permlane32_swap(__float_as_uint(m), __float_as_uint(m), false, false);
  return max2f(__uint_as_float(rr[0]), __uint_as_float(rr[1]));
}
__device__ __forceinline__ void pv(f32x16* o, int vb, bf16x8 pa0, bf16x8 pa1, bf16x8 pa2, bf16x8 pa3) {
  #pragma unroll
  for (int d0 = 0; d0 < 2; ++d0) { s16x4 lo[4], hi[4];
    #pragma unroll
    for (int ks = 0; ks < 4; ++ks) {
      asm volatile("ds_read_b64_tr_b16 %0,%1 offset:%c2" : "=&v"(lo[ks]) : "v"(vb), "i"(d0 * 4096 + ks * 1024) : "memory");
      asm volatile("ds_read_b64_tr_b16 %0,%1 offset:%c2" : "=&v"(hi[ks]) : "v"(vb), "i"(d0 * 4096 + ks * 1024 + 512) : "memory"); }
    asm volatile("s_waitcnt lgkmcnt(0)" ::: "memory"); SBAR();
    #define PK(k) (bf16x8){lo[k][0], lo[k][1], lo[k][2], lo[k][3], hi[k][0], hi[k][1], hi[k][2], hi[k][3]}
    o[d0] = __builtin_amdgcn_mfma_f32_32x32x16_bf16(pa0, PK(0), o[d0], 0, 0, 0);
    o[d0] = __builtin_amdgcn_mfma_f32_32x32x16_bf16(pa1, PK(1), o[d0], 0, 0, 0);
    o[d0] = __builtin_amdgcn_mfma_f32_32x32x16_bf16(pa2, PK(2), o[d0], 0, 0, 0);
    o[d0] = __builtin_amdgcn_mfma_f32_32x32x16_bf16(pa3, PK(3), o[d0], 0, 0, 0);
    #undef PK
  }
}
template <int NDV> __device__ __forceinline__ void pvn(f32x16* o, int vb, bf16x8 pa0, bf16x8 pa1, bf16x8 pa2, bf16x8 pa3) {
  #pragma unroll
  for (int d0 = 0; d0 < NDV; ++d0) { s16x4 lo[4], hi[4];
    #pragma unroll
    for (int ks = 0; ks < 4; ++ks) {
      asm volatile("ds_read_b64_tr_b16 %0,%1 offset:%c2" : "=&v"(lo[ks]) : "v"(vb), "i"(d0 * 4096 + ks * 1024) : "memory");
      asm volatile("ds_read_b64_tr_b16 %0,%1 offset:%c2" : "=&v"(hi[ks]) : "v"(vb), "i"(d0 * 4096 + ks * 1024 + 512) : "memory"); }
    asm volatile("s_waitcnt lgkmcnt(0)" ::: "memory"); SBAR();
    #define PK(k) (bf16x8){lo[k][0], lo[k][1], lo[k][2], lo[k][3], hi[k][0], hi[k][1], hi[k][2], hi[k][3]}
    o[d0] = __builtin_amdgcn_mfma_f32_32x32x16_bf16(pa0, PK(0), o[d0], 0, 0, 0);
    o[d0] = __builtin_amdgcn_mfma_f32_32x32x16_bf16(pa1, PK(1), o[d0], 0, 0, 0);
    o[d0] = __builtin_amdgcn_mfma_f32_32x32x16_bf16(pa2, PK(2), o[d0], 0, 0, 0);
    o[d0] = __builtin_amdgcn_mfma_f32_32x32x16_bf16(pa3, PK(3), o[d0], 0, 0, 0);
    #undef PK
  }
}
template <int NDV> __device__ __forceinline__ void attn_unit(const bf16_t* Qu, const bf16_t* __restrict__ Kh, const bf16_t* __restrict__ Vh, bf16_t* Ou, const int NT, char* shm, const float* gq, const float* invt, const int pos0) {
  constexpr int NV = NDV / 2, VSLOT = 4096 * NDV;
  constexpr int L_K = 0, L_V = 3 * 8192, L_WS = L_V + 3 * VSLOT, L_OST = L_WS + NW * 64 * 4;
  const int tid = opq_tid(), lane = tid & 63, r32 = lane & 31, hi = lane >> 5; const int wid = __builtin_amdgcn_readfirstlane(tid >> 6);
  const bf16_t* Qw = Qu + (long)(wid * QBLK) * PU;
  const unsigned lds0 = (unsigned)(uintptr_t)shm;
  float* wsf = (float*)(shm + L_WS) + wid * 64;
  const bf16_t* ksrc = Kh + (long)lane * PU + wid * 8;
  const bf16_t* vsrc = Vh + (long)(16 * (wid & 3) + (lane >> 2)) * PU + (wid >> 2) * 32 + (lane & 3) * 8;
  const unsigned kdst = lds0 + L_K + wid * 1024, vdst = lds0 + L_V + wid * 1024;
  #define DMA_K(t, si) glds16(ksrc + (long)(t) * KVBLK * PU, (unsigned)__builtin_amdgcn_readfirstlane(kdst + (si) * 8192))
  #define DMA_V(t, si) do { glds16(vsrc + (long)(t) * KVBLK * PU, (unsigned)__builtin_amdgcn_readfirstlane(vdst + (si) * VSLOT)); \
      if (NV == 2) glds16(vsrc + 64 + (long)(t) * KVBLK * PU, (unsigned)__builtin_amdgcn_readfirstlane(vdst + (si) * VSLOT + 8192)); } while (0)
  const int vb0 = (int)(lds0 + L_V) + ((lane >> 4) & 1) * 32 + (lane & 3) * 8 + (4 * hi + ((lane & 15) >> 2)) * 64;
  const char* Kbase = shm + L_K; bf16x8 kf[8];
  const lds_cptr shm3 = (lds_cptr)shm; const lds_cptr kp0 = shm3 + L_K + hi * 1024 + r32 * 16; const lds_cptr vp0 = shm3 + L_V + ((lane >> 4) & 1) * 32 + (lane & 3) * 8 + (4 * hi + ((lane & 15) >> 2)) * 64;
  DMA_K(0, 0); DMA_V(0, 0); DMA_K(1, 1);
  bf16x8 qr[4];
  { bf16x8 qraw[4];
    #pragma unroll
    for (int d0 = 0; d0 < 4; ++d0) qraw[d0] = *reinterpret_cast<const bf16x8*>(&Qw[(long)r32 * PU + d0 * 16 + hi * 8]);
    float x[4][8]; float ss = 0.f;
    #pragma unroll
    for (int d0 = 0; d0 < 4; ++d0)
      #pragma unroll
      for (int j = 0; j < 8; ++j) { x[d0][j] = __builtin_bit_cast(float, (unsigned)(unsigned short)qraw[d0][j] << 16); ss += x[d0][j] * x[d0][j]; }
    ss += shx<32>(ss);
    const float rstd = rsqrtf(ss * (1.f / 64.f) + EPS);
    #pragma unroll
    for (int d0 = 0; d0 < 4; ++d0) { const f32x4 ga = *(const f32x4*)(gq + 16 * d0 + 8 * hi), gb = *(const f32x4*)(gq + 16 * d0 + 8 * hi + 4);
      x[d0][0] *= rstd * ga.x; x[d0][1] *= rstd * ga.y; x[d0][2] *= rstd * ga.z; x[d0][3] *= rstd * ga.w; x[d0][4] *= rstd * gb.x; x[d0][5] *= rstd * gb.y; x[d0][6] *= rstd * gb.z; x[d0][7] *= rstd * gb.w; }
    const int pos = pos0 + wid * QBLK + r32;
    if (NDV == 2) {
      const float fr = (float)(pos >> 6), fc = (float)(pos & 63);
      #pragma unroll
      for (int j = 0; j < 8; ++j) { const float ih = invt[2 * (20 + 8 * hi + j)], il = invt[2 * (20 + 8 * hi + j) + 1];
        const float rr = __builtin_amdgcn_fractf(fr * ih) + fr * il, rc = __builtin_amdgcn_fractf(fc * ih) + fc * il;
        const float c1 = __builtin_amdgcn_cosf(rr), s1 = __builtin_amdgcn_sinf(rr), c2 = __builtin_amdgcn_cosf(rc), s2 = __builtin_amdgcn_sinf(rc);
        const float a = x[0][j], b = x[1][j], c = x[2][j], d = x[3][j];
        x[0][j] = a * c1 - b * s1; x[1][j] = b * c1 + a * s1; x[2][j] = c * c2 - d * s2; x[3][j] = d * c2 + c * s2; }
    } else {
      const float fp = (float)pos;
      #pragma unroll
      for (int j = 0; j < 8; ++j) { const float ih = invt[2 * (12 + j)], il = invt[2 * (12 + j) + 1];
        const float rv = __builtin_amdgcn_fractf(fp * ih) + fp * il; const float c1 = __builtin_amdgcn_cosf(rv), s1 = __builtin_amdgcn_sinf(rv);
        const float pr = shx<32>(x[0][j]);
        x[0][j] = x[0][j] * c1 + ((hi == 0) ? -pr : pr) * s1; }
    }
    #pragma unroll
    for (int d0 = 0; d0 < 4; ++d0) { u32x4 w; w.x = cvtpk_s(x[d0][0] * C2_64, x[d0][1] * C2_64); w.y = cvtpk_s(x[d0][2] * C2_64, x[d0][3] * C2_64); w.z = cvtpk_s(x[d0][4] * C2_64, x[d0][5] * C2_64); w.w = cvtpk_s(x[d0][6] * C2_64, x[d0][7] * C2_64);
      qr[d0] = __builtin_bit_cast(bf16x8, w); } }
  float l_reg = 0.f; f32x16 o[NDV];
  #pragma unroll
  for (int d0 = 0; d0 < NDV; ++d0) o[d0] = f32x16{};
  const f32x16 zero16 = f32x16{};
  f32x16 pA0, pA1, pB0, pB1;
  int i_prev = 0, i_cur = 0, i_next = 1;
  #define ROT() do { i_prev = i_cur; i_cur = i_next; i_next = (i_next == 2) ? 0 : i_next + 1; } while (0)
  #define WAIT_STEADY() do { if (NV == 1) { WAIT_BAR(2); } else { WAIT_BAR(3); } } while (0)
  #define WAIT_VONLY() do { if (NV == 1) { WAIT_BAR(1); } else { WAIT_BAR(2); } } while (0)
  DMA_K(2, 2);
  if (NV == 1) { WAIT_BAR(3); } else { WAIT_BAR(4); }
  qkt(pA0, pA1, Kbase, qr, zero16, r32, hi);
  _Pragma("unroll") for (int r = 0; r < 16; ++r) { pA0[r] = __builtin_amdgcn_exp2f(pA0[r]); pA1[r] = __builtin_amdgcn_exp2f(pA1[r]); }
  WAIT_BAR(0);
  DMA_K(3, 0); DMA_V(1, 1);
  ROT();
  kload8(kf, kp0 + i_cur * 8192);
  WAIT_STEADY();
  s16x4 vlo[8], vhi[8]; u32x4 pw0, pw1, pw2, pw3;
  #define PKW(P, B) cvtpk_s(P[B], P[B + 1])
  #define PAF(k) __builtin_bit_cast(bf16x8, pw##k)
  #define VFR(i) (bf16x8){vlo[i][0], vlo[i][1], vlo[i][2], vlo[i][3], vhi[i][0], vhi[i][1], vhi[i][2], vhi[i][3]}
  #define PIN(x) asm volatile("" : "+v"(x))
  #define GAPA(MF, A0, A1, A2, A3, W0, W1, PW) do { MF; sacc += A0; sacc += A1; sacc += A2; sacc += A3; PIN(sacc); W0; W1; PIN(PW); SBAR(); } while (0)
  #define EX(v) __builtin_amdgcn_exp2f(v)
  #define GAPB(MF, X, B) do { MF; X[B] = EX(X[B]); X[B + 1] = EX(X[B + 1]); X[B + 2] = EX(X[B + 2]); X[B + 3] = EX(X[B + 3]); PIN(X); SBAR(); } while (0)
  #define GAPB2(MF, X, B) do { MF; X[B] = EX(X[B]); X[B + 1] = EX(X[B + 1]); PIN(X); SBAR(); } while (0)
  #define VRD(i) do { vlo[i] = vtr(vp_ + (((i) >> 2) * 4096 + ((i) & 3) * 1024)); vhi[i] = vtr(vp_ + (((i) >> 2) * 4096 + ((i) & 3) * 1024 + 512)); } while (0)
  #define VRD2(i) do { vlo[i] = vtr(vp_ + ((((i) >> 2) + 2) * 4096 + ((i) & 3) * 1024)); vhi[i] = vtr(vp_ + ((((i) >> 2) + 2) * 4096 + ((i) & 3) * 1024 + 512)); SBAR(); } while (0)
  #define KRD(G, j) do { if (G) { kload2(kf, kp0 + i_next * 8192, j); SBAR(); } } while (0)
  #define MFO(d, k, v) o[d] = __builtin_amdgcn_mfma_f32_32x32x16_bf16(PAF(k), VFR(v), o[d], 0, 0, 0)
  #define STEP(C0, C1, P0, P1, t, GK, GV, GL) do { SBAR(); \
    const lds_cptr vp_ = vp0 + i_prev * VSLOT; \
    VRD(0); SBAR(); float sacc = (P0[0] + P0[1]); \
    GAPA(C0 = __builtin_amdgcn_mfma_f32_32x32x16_bf16(kf[0], qr[0], zero16, 0, 0, 0), P0[2], P0[3], P0[4], P0[5],     pw0[0] = PKW(P0, 0), pw0[1] = PKW(P0, 2), pw0); \
    VRD(4); SBAR(); GAPA(C1 = __builtin_amdgcn_mfma_f32_32x32x16_bf16(kf[1], qr[0], zero16, 0, 0, 0), P0[6], P0[7], P0[8], P0[9],     pw0[2] = PKW(P0, 4), pw0[3] = PKW(P0, 6), pw0); \
    VRD(1); SBAR(); GAPA(C0 = __builtin_amdgcn_mfma_f32_32x32x16_bf16(kf[2], qr[1], C0, 0, 0, 0),   P0[10], P0[11], P0[12], P0[13], pw1[0] = PKW(P0, 8), pw1[1] = PKW(P0, 10), pw1); \
    VRD(5); SBAR(); GAPA(C1 = __builtin_amdgcn_mfma_f32_32x32x16_bf16(kf[3], qr[1], C1, 0, 0, 0),   P0[14], P0[15], P1[0], P1[1],   pw1[2] = PKW(P0, 12), pw1[3] = PKW(P0, 14), pw1); \
    VRD(2); SBAR(); GAPA(C0 = __builtin_amdgcn_mfma_f32_32x32x16_bf16(kf[4], qr[2], C0, 0, 0, 0),   P1[2], P1[3], P1[4], P1[5],     pw2[0] = PKW(P1, 0), pw2[1] = PKW(P1, 2), pw2); \
    VRD(6); SBAR(); GAPA(C1 = __builtin_amdgcn_mfma_f32_32x32x16_bf16(kf[5], qr[2], C1, 0, 0, 0),   P1[6], P1[7], P1[8], P1[9],     pw2[2] = PKW(P1, 4), pw2[3] = PKW(P1, 6), pw2); \
    VRD(3); SBAR(); GAPA(C0 = __builtin_amdgcn_mfma_f32_32x32x16_bf16(kf[6], qr[3], C0, 0, 0, 0),   P1[10], P1[11], P1[12], P1[13], pw3[0] = PKW(P1, 8), pw3[1] = PKW(P1, 10), pw3); \
    VRD(7); SBAR(); GAPA(C1 = __builtin_amdgcn_mfma_f32_32x32x16_bf16(kf[7], qr[3], C1, 0, 0, 0),   P1[14], P1[15], 0.f, 0.f,       pw3[2] = PKW(P1, 12), pw3[3] = PKW(P1, 14), pw3); \
    l_reg += sacc; \
    if (GK) { DMA_K((t) + 3, i_cur); } if (GV) { DMA_V((t) + 1, i_next); } \
    SBAR(); \
    if (NDV == 2) { \
      GAPB(MFO(0, 0, 0), C0, 0); \
      GAPB(MFO(1, 0, 4), C0, 4); \
      KRD(GL, 0); GAPB(MFO(0, 1, 1), C0, 8); \
      KRD(GL, 1); GAPB(MFO(1, 1, 5), C0, 12); \
      KRD(GL, 2); GAPB(MFO(0, 2, 2), C1, 0); \
      KRD(GL, 3); GAPB(MFO(1, 2, 6), C1, 4); \
      GAPB(MFO(0, 3, 3), C1, 8); \
      GAPB(MFO(1, 3, 7), C1, 12); \
    } else { \
      GAPB2(MFO(0, 0, 0), C0, 0); VRD2(0); \
      GAPB2(MFO(1, 0, 4), C0, 2); VRD2(4); \
      KRD(GL, 0); GAPB2(MFO(0, 1, 1), C0, 4); VRD2(1); \
      KRD(GL, 1); GAPB2(MFO(1, 1, 5), C0, 6); VRD2(5); \
      KRD(GL, 2); GAPB2(MFO(0, 2, 2), C0, 8); VRD2(2); \
      KRD(GL, 3); GAPB2(MFO(1, 2, 6), C0, 10); VRD2(6); \
      GAPB2(MFO(0, 3, 3), C0, 12); VRD2(3); \
      GAPB2(MFO(1, 3, 7), C0, 14); VRD2(7); \
      GAPB2(MFO(NDV - 2, 0, 0), C1, 0); \
      GAPB2(MFO(NDV - 1, 0, 4), C1, 2); \
      GAPB2(MFO(NDV - 2, 1, 1), C1, 4); \
      GAPB2(MFO(NDV - 1, 1, 5), C1, 6); \
      GAPB2(MFO(NDV - 2, 2, 2), C1, 8); \
      GAPB2(MFO(NDV - 1, 2, 6), C1, 10); \
      GAPB2(MFO(NDV - 2, 3, 3), C1, 12); \
      GAPB2(MFO(NDV - 1, 3, 7), C1, 14); \
    } \
    } while (0)
  int t = 1;
  for (; t + 5 < NT; t += 2) {
    STEP(pB0, pB1, pA0, pA1, t, true, true, true);     WAIT_STEADY(); ROT();
    STEP(pA0, pA1, pB0, pB1, t + 1, true, true, true); WAIT_STEADY(); ROT();
  }
  #define ENDW(tt) do { if ((tt) + 3 < NT) { WAIT_STEADY(); } else if ((tt) + 2 < NT) { WAIT_VONLY(); } else { WAIT_BAR(0); } } while (0)
  for (; t + 1 < NT; t += 2) {
    STEP(pB0, pB1, pA0, pA1, t, (t + 3 < NT), (t + 1 < NT), (t + 1 < NT));         ENDW(t);     ROT();
    STEP(pA0, pA1, pB0, pB1, t + 1, (t + 4 < NT), (t + 2 < NT), (t + 2 < NT));     ENDW(t + 1); ROT();
  }
  STEP(pB0, pB1, pA0, pA1, NT - 1, false, false, false);
  { float sacc = pB0[0] + pB0[1]; _Pragma("unroll") for (int r = 2; r < 16; ++r) sacc += pB0[r]; _Pragma("unroll") for (int r = 0; r < 16; ++r) sacc += pB1[r]; l_reg += sacc;
    pw0 = (u32x4){PKW(pB0, 0), PKW(pB0, 2), PKW(pB0, 4), PKW(pB0, 6)}; pw1 = (u32x4){PKW(pB0, 8), PKW(pB0, 10), PKW(pB0, 12), PKW(pB0, 14)}; pw2 = (u32x4){PKW(pB1, 0), PKW(pB1, 2), PKW(pB1, 4), PKW(pB1, 6)}; pw3 = (u32x4){PKW(pB1, 8), PKW(pB1, 10), PKW(pB1, 12), PKW(pB1, 14)};
    SBAR(); pvn<NDV>(o, vb0 + i_cur * VSLOT, PAF(0), PAF(1), PAF(2), PAF(3)); }
  #undef PKW
  #undef PAF
  #undef VFR
  #undef PIN
  #undef GAPA
  #undef GAPB
  #undef GAPB2
  #undef EX
  #undef VRD
  #undef VRD2
  #undef KRD
  #undef MFO
  #undef STEP
  #undef ENDW
  { auto rr = __builtin_amdgcn_permlane32_swap(__float_as_uint(l_reg), __float_as_uint(l_reg), false, false); l_reg = __uint_as_float(rr[0]) + __uint_as_float(rr[1]); }
  if (hi == 0) wsf[32 + r32] = l_reg; asm volatile("s_waitcnt lgkmcnt(0)" ::: "memory");
  float rli[16];
  #pragma unroll
  for (int r = 0; r < 16; ++r) rli[r] = __builtin_amdgcn_rcpf(wsf[32 + crow(r, hi)]);
  bf16_t* Ow = Ou + (long)(wid * QBLK) * PO;
  { bf16_t* stg = (bf16_t*)(shm + L_OST) + wid * 2048;
    #pragma unroll
    for (int h = 0; h < NV; ++h) {
      #pragma unroll
      for (int r = 0; r < 16; ++r) { const int orow = crow(r, hi);
        #pragma unroll
        for (int d0 = 0; d0 < 2; ++d0) stg[orow * 64 + d0 * 32 + r32] = (bf16_t)f2bf(o[2 * h + d0][r] * rli[r]); }
      asm volatile("s_waitcnt lgkmcnt(0)" ::: "memory");
      #pragma unroll
      for (int i = 0; i < 4; ++i) { const int row = i * 8 + (lane >> 3), ch = lane & 7; const u32x4 v = *(const u32x4*)(stg + row * 64 + ch * 8); *(u32x4*)(Ow + (long)row * PO + h * 64 + ch * 8) = v; }
      asm volatile("s_waitcnt lgkmcnt(0)" ::: "memory"); } }
  asm volatile("s_waitcnt lgkmcnt(0)\n\ts_barrier" ::: "memory");
  #undef DMA_K
  #undef DMA_V
  #undef ROT
  #undef WAIT_STEADY
  #undef WAIT_VONLY
}
#undef SBAR
#undef WAIT_BAR
}

__device__ __forceinline__ void transpose_item(const float* W, int N, bf16_t* WT, int ldt, int row_off, int koff, LAS float* scr, int item, int lane) {
    const int nblk = N / 32, kb = item / nblk, nb = item % nblk, k0 = 64 * kb, n0 = 32 * nb;
#pragma unroll 8
    for (int i = 0; i < 32; ++i) { const int kk = 2 * i + (lane >> 5); scr[kk * 33 + (lane & 31)] = W[(size_t)(k0 + kk) * N + n0 + (lane & 31)]; }
    LDS_WAIT(); asm volatile("" ::: "memory");
    const int c = lane & 7;
#pragma unroll
    for (int j = 0; j < 4; ++j) { const int n = (lane >> 3) + 8 * j; const LAS float* s = scr + (8 * c) * 33 + n;
        u32x4 o; o.x = pk2(s[0 * 33], s[1 * 33]); o.y = pk2(s[2 * 33], s[3 * 33]); o.z = pk2(s[4 * 33], s[5 * 33]); o.w = pk2(s[6 * 33], s[7 * 33]);
        *(u32x4*)(WT + (size_t)(row_off + n0 + n) * ldt + koff + k0 + 8 * c) = o; }
    LDS_WAIT(); asm volatile("" ::: "memory");
}

#define XB_TMO      128
#define XB_XCNT(j)  (256  + 64 * (j))
#define XB_XSUB(j)  (1280 + 64 * (j))
#define XB_XGEN(j)  (2304 + 64 * (j))
#define XB_TOP      3328
#define XB_TOPGEN   3392
#define XCD_BAR_WORDS 3456
#define XB_SPIN_CAP (1u << 22)
__device__ __forceinline__ unsigned xb_ld(unsigned* p)              { return __hip_atomic_load(p, __ATOMIC_RELAXED, __HIP_MEMORY_SCOPE_AGENT); }
__device__ __forceinline__ unsigned xb_add(unsigned* p, unsigned v) { return __hip_atomic_fetch_add(p, v, __ATOMIC_RELAXED, __HIP_MEMORY_SCOPE_AGENT); }
__device__ __forceinline__ unsigned xb_xcc_id() { return (unsigned)__builtin_amdgcn_s_getreg((3 << 11) | 20) & 0xFu; }
#define XB_SPIN(cond, bar) do { unsigned _sp = 0; while (cond) { __builtin_amdgcn_s_sleep(1); \
    if ((++_sp & 255u) == 0u) { if (xb_ld(&(bar)[XB_TMO])) break; if (_sp > XB_SPIN_CAP) { atomicAdd(&(bar)[XB_TMO], 1u); break; } } } } while (0)
struct XcdBarrier { unsigned* bar; unsigned x; volatile LAS unsigned* st; };
__device__ __forceinline__ XcdBarrier xcd_barrier_post(unsigned* bar, volatile LAS unsigned* st) {
    XcdBarrier b; b.bar = bar; b.x = xb_xcc_id(); b.st = st;
    if (threadIdx.x == 0) (void)xb_add(&bar[XB_XCNT(b.x)], 1u);
    return b;
}
__device__ __forceinline__ void xcd_barrier_complete(unsigned* bar, unsigned x, unsigned& nloc, unsigned& nx) {
    const unsigned G = gridDim.x * gridDim.y * gridDim.z;
    unsigned sum, cnt, mine, sp = 0u;
    for (;;) {
        sum = 0u; cnt = 0u; mine = 0u;
#pragma unroll
        for (unsigned j = 0; j < 16; ++j) { const unsigned c = xb_ld(&bar[XB_XCNT(j)]); sum += c; cnt += (c > 0u) ? 1u : 0u; mine = (j == x) ? c : mine; }
        if (sum == G) break;
        __builtin_amdgcn_s_sleep(1);
        if ((++sp & 255u) == 0u) { if (xb_ld(&bar[XB_TMO])) break; if (sp > XB_SPIN_CAP) { atomicAdd(&bar[XB_TMO], 1u); break; } }
    }
    nloc = mine > 0u ? mine : 1u; nx = cnt > 0u ? cnt : 1u;
}
__device__ __forceinline__ void xcd_barrier(const XcdBarrier& b) {
    asm volatile("s_waitcnt vmcnt(0)" ::: "memory");
    __syncthreads();
    if (threadIdx.x == 0) {
        unsigned* bar = b.bar; unsigned bx_ = b.x;
        asm volatile("" : "+s"(bar), "+s"(bx_));
        __builtin_amdgcn_s_waitcnt(0);
        unsigned nloc = b.st[0], nx = b.st[1];
        if (nloc == 0u) { xcd_barrier_complete(bar, bx_, nloc, nx); b.st[0] = nloc; b.st[1] = nx; }
        const unsigned old = xb_add(&bar[XB_XSUB(bx_)], 1u);
        const unsigned gen = old / nloc;
        if (old + 1u == (gen + 1u) * nloc) {
            __builtin_amdgcn_fence(__ATOMIC_RELEASE, "agent");
            asm volatile("s_waitcnt vmcnt(0)" ::: "memory");
            const unsigned og = xb_add(&bar[XB_TOP], 1u);
            const unsigned tg = og / nx;
            if (og + 1u == (tg + 1u) * nx) xb_add(&bar[XB_TOPGEN], 1u);
            else XB_SPIN(xb_ld(&bar[XB_TOPGEN]) == tg, bar);
            __builtin_amdgcn_fence(__ATOMIC_ACQUIRE, "agent");
            xb_add(&bar[XB_XGEN(bx_)], 1u);
            asm volatile("s_waitcnt vmcnt(0)" ::: "memory");
        } else {
            XB_SPIN(xb_ld(&bar[XB_XGEN(bx_)]) == gen, bar);
            __builtin_amdgcn_fence(__ATOMIC_ACQUIRE, "agent");
            asm volatile("s_waitcnt vmcnt(0)" ::: "memory");
        }
    }
    __syncthreads();
}

__device__ __forceinline__ int ltperm(int n) { const int t = n >> 8, r = n & 255, half = t >> 5, idx = t & 31; return ((((idx >> 2) * 8) + (half ? 0 : 4) + (idx & 3)) << 8) | r; }
__device__ __forceinline__ int seq_of(int chunk, int lt) { return (chunk == 0) ? (lt >> 11) : (8 + 2 * (chunk - 1) + (lt >> 13)); }

#define NORM_PHASE(L_, C_) do { const int l = (L_), chunk = (C_); const size_t tb = (size_t)chunk * CH; if (PH & 1) { PHASE_PTRS(); CHUNK_PTRS(); bf16_t* HN = OB; \
    for (int lt = gw; lt < CH; lt += NGW) { \
        const int s = seq_of(chunk, lt); \
        const f32x4* xr = (const f32x4*)(xin + (size_t)lt * DM) + lane; \
        f32x4 v[4]; float ss = 0.f; \
        _Pragma("unroll") for (int j = 0; j < 4; ++j) { v[j] = xr[64 * j]; ss += (v[j].x * v[j].x + v[j].y * v[j].y) + (v[j].z * v[j].z + v[j].w * v[j].w); } \
        const float rstd = rsqrtf(wave_sum(ss) * (1.f / DM) + EPS); \
        u32x2* o8 = (u32x2*)(HN + (size_t)lt * DM) + lane; \
        _Pragma("unroll") for (int j = 0; j < 4; ++j) { const int c = 4 * lane + 256 * j; \
            const f32x4 gn = *(const f32x4*)(PIN(4) + l * DM + c), sh = *(const f32x4*)(modl + s * 3072 + c), scl = *(const f32x4*)(modl + s * 3072 + 1024 + c); \
            const f32x4 y = v[j] * rstd * gn * (scl + 1.0f) + sh; \
            u32x2 w; w.x = pk2(y.x, y.y); w.y = pk2(y.z, y.w); o8[64 * j] = w; } \
    } } } while (0)

__global__ void __launch_bounds__(512, 2) fwd_megakernel(Params p) {
    extern __shared__ __attribute__((aligned(16))) unsigned char lds[];
    cg::grid_group grid = cg::this_grid();
    const int G = gridDim.x, bx = blockIdx.x, NGW = G * 8;
    unsigned char* ws = p.ws;
#define PHASE_PTRS() unsigned char* wsl = opq(ws); const int tid = opq_tid(), lane = tid & 63, wave = __builtin_amdgcn_readfirstlane(tid >> 6), gw = bx * 8 + wave; (void)lane; (void)gw; \
    float* MOD = (float*)(wsl + WS_MOD); float* SC = (float*)(wsl + WS_SC); float* TAB = (float*)(wsl + WS_TAB); \
    bf16_t* WIN = (bf16_t*)(wsl + WS_WIN); bf16_t* WO = (bf16_t*)(wsl + WS_WO); bf16_t* WOUT = (bf16_t*)(wsl + WS_WOUT); \
    bf16_t* H = (bf16_t*)(wsl + WS_H); float* LA = (float*)(wsl + WS_LA); bf16_t* VAT = (bf16_t*)(wsl + WS_VAT); bf16_t* Y = (bf16_t*)(wsl + WS_VAT); \
    bf16_t* OB = (bf16_t*)(wsl + WS_OB); bf16_t* U = (bf16_t*)(wsl + WS_U); \
    (void)MOD; (void)SC; (void)TAB; (void)WIN; (void)WO; (void)WOUT; (void)H; (void)LA; (void)VAT; (void)Y; (void)OB; (void)U;
#define PIN(i) opq(p.in[i])
#define CHUNK_PTRS() const float* modl = MOD + (size_t)l * 12 * 3072; \
    const float* xin = (l == 0) ? ((chunk == 0) ? PIN(0) : PIN(1) + (tb - CH) * DM) : (opq(p.out) + tb * DM); \
    float* xout = opq(p.out) + tb * DM; (void)modl; (void)xin; (void)xout;
    LAS unsigned char* ldsl = (LAS unsigned char*)lds;
    if (threadIdx.x < 64) ((LAS unsigned*)(ldsl + RING_BYTES))[threadIdx.x] = 0u;
    __syncthreads();
    if (blockIdx.x == 0) for (int i = threadIdx.x; i < 4096; i += 512) ((unsigned*)(ws + WS_BAR))[i] = 0u;

    for (int rep = 0; rep < ((DUP & 1024) ? 2 : 1); ++rep) if (PH & 256) {
        PHASE_PTRS();
        LAS float* scr = (LAS float*)(ldsl + wave * 16384);
        constexpr int I_IN = 16 * 216, I_BG = 16 * 96, I_OA = 6 * 32, I_OB = 6 * 32, I_OC = 8 * 32, I_OUT = 16 * 32;
        constexpr int I_L = I_IN + I_BG + I_OA + I_OB + I_OC + I_OUT;
        for (int it = gw; it < 2 * I_L; it += NGW) {
            const int l = it / I_L; int r = it % I_L;
            if (r < I_IN) { transpose_item(PIN(7) + (size_t)l * 1024 * 6912, 6912, WIN + (size_t)l * LDU * 1024, 1024, 0, 0, scr, r, lane); continue; } r -= I_IN;
            if (r < I_BG) { transpose_item(PIN(22) + (size_t)l * 1024 * 3072, 3072, WIN + (size_t)l * LDU * 1024, 1024, 6912, 0, scr, r, lane); continue; } r -= I_BG;
            if (r < I_OA) { transpose_item(PIN(19) + (size_t)l * 384 * 1024, 1024, WO + (size_t)l * 1024 * LDY, LDY, 0, 0, scr, r, lane); continue; } r -= I_OA;
            if (r < I_OB) { transpose_item(PIN(20) + (size_t)l * 384 * 1024, 1024, WO + (size_t)l * 1024 * LDY, LDY, 0, 384, scr, r, lane); continue; } r -= I_OB;
            if (r < I_OC) { transpose_item(PIN(21) + (size_t)l * 512 * 1024, 1024, WO + (size_t)l * 1024 * LDY, LDY, 0, 768, scr, r, lane); continue; } r -= I_OC;
            transpose_item(PIN(24) + (size_t)l * 1024 * 1024, 1024, WOUT + (size_t)l * 1024 * 1024, 1024, 0, 0, scr, r, lane);
        }
        __syncthreads();
        {
            LAS float* sc = (LAS float*)ldsl;
            LAS float* part = (LAS float*)(ldsl + 49152);
            for (int item = bx; item < 96; item += G) {
                const int l = item / 48, cb = item % 48;
                for (int idx = lane; idx < 12 * 128; idx += 64) { const int s = idx >> 7, kk = idx & 127;
                    const float cv = (s < 8) ? PIN(2)[s * 1024 + 128 * wave + kk] : PIN(3)[(s - 8) * 1024 + 128 * wave + kk];
                    sc[(wave * 12 + s) * 128 + kk] = cv * sigmoidf_(cv); }
                LDS_WAIT(); asm volatile("" ::: "memory");
                float a[12];
#pragma unroll
                for (int s = 0; s < 12; ++s) a[s] = 0.f;
                const float* wp = PIN(5) + (size_t)l * 1024 * 3072 + (size_t)(128 * wave) * 3072 + cb * 64 + lane;
#pragma unroll 4
                for (int kk = 0; kk < 128; ++kk) { const float wv = wp[(size_t)kk * 3072];
#pragma unroll
                    for (int s = 0; s < 12; ++s) a[s] += sc[(wave * 12 + s) * 128 + kk] * wv; }
#pragma unroll
                for (int s = 0; s < 12; ++s) part[(wave * 12 + s) * 64 + lane] = a[s];
                __syncthreads();
                for (int o = tid; o < 768; o += 512) { const int s = o >> 6, ln = o & 63; float v = PIN(6)[l * 3072 + cb * 64 + ln];
#pragma unroll
                    for (int w = 0; w < 8; ++w) v += part[(w * 12 + s) * 64 + ln];
                    MOD[((size_t)l * 12 + s) * 3072 + cb * 64 + ln] = v; }
                __syncthreads();
            }
        }
        if (bx == 0 && wave == 0) {
            if (lane < 36) { double inv = 0.0;
#pragma unroll
                for (int i = 0; i < 36; ++i) inv = (lane == i) ? p.inv[i] : inv;
                const float h = __builtin_bit_cast(float, __builtin_bit_cast(unsigned, (float)inv) & 0xFFFFC000u);
                SC[16 + 2 * lane] = h; SC[16 + 2 * lane + 1] = (float)(inv - (double)h); }
            for (int l = 0; l < 2; ++l) {
                const float d1 = wave_sum(PIN(14)[l * 64 + lane] * PIN(15)[l * 64 + lane]);
                const float d2 = wave_sum(PIN(16)[l * 64 + lane] * PIN(17)[l * 64 + lane]);
                const float lam_init = (l == 0) ? 0.2f : 0.35550906759096926f;
                float mq = fmaxf(fabsf(PIN(8)[l * 96 + lane]), (lane < 32) ? fabsf(PIN(8)[l * 96 + 64 + lane]) : 0.f);
                float mk = fmaxf(fabsf(PIN(9)[l * 96 + lane]), (lane < 32) ? fabsf(PIN(9)[l * 96 + 64 + lane]) : 0.f);
                mq = wave_max(mq); mk = wave_max(mk);
                if (lane == 0) { SC[l] = __expf(d1) - __expf(d2) + lam_init; SC[2 + l] = -(9.797958971132712f * mq * mk * LOG2E + 0.5f); }
            }
        }
    }
    grid.sync();
    const XcdBarrier xbar = xcd_barrier_post((unsigned*)(ws + WS_BAR), (volatile LAS unsigned*)(ldsl + RING_BYTES + 32));
    NORM_PHASE(0, 0);
    GSYNC();

    for (int l = 0; l < 2; ++l) {
        const float lam_init = (l == 0) ? 0.2f : 0.35550906759096926f;
        for (int chunk = 0; chunk < NCHUNK; ++chunk) {
            const int SL = (chunk == 0) ? 2048 : 8192, SLsh = (chunk == 0) ? 11 : 13;
            const size_t tb = (size_t)chunk * CH;

            for (int rep = 0; rep < ((DUP & 2) ? 2 : 1); ++rep) if (PH & 2) {
                PHASE_PTRS(); CHUNK_PTRS();
                pg8::Gemm g{OB, WIN + (size_t)l * LDU * 1024, CH, LDU, 1024, 1024, 1024};
                pg8::StaticOrder S; S.init(CH, LDU, G, bx);
                pg8::EpiU E{U, PIN(23) + l * 3072};
                pg8::gemm_phase<pg8::EpiU, true>(ldsl, g, S, E);
            }
            GSYNC();

            if (PH & 4) {
                PHASE_PTRS(); CHUNK_PTRS();
                const float* qn_a = PIN(8) + l * 96; const float* kn_a = PIN(9) + l * 96;
                const float* qn_b = PIN(10) + l * 64; const float* kn_b = PIN(11) + l * 64;
                const float* qn_c = PIN(12) + l * 64; const float* kn_c = PIN(13) + l * 64;
                const int sub = lane >> 3, ll = lane & 7;
                const float* INVT = SC + 16;
                {
                    constexpr int NB = 4;
                    float gq[12], gk[12], ihi[12], ilo[12];
#pragma unroll
                    for (int e2 = 0; e2 < 12; ++e2) { gq[e2] = qn_a[12 * ll + e2]; gk[e2] = kn_a[12 * ll + e2]; ihi[e2] = INVT[2 * e2]; ilo[e2] = INVT[2 * e2 + 1]; }
                    const bool rot = ll < 2, first = ll == 0;
                    for (int it0 = gw; it0 < CH * 3; it0 += NGW * NB) {
                        u32x4 wa[NB]; u32x2 wb[NB];
#pragma unroll
                        for (int b = 0; b < NB; ++b) { const int it = min(it0 + b * NGW, CH * 3 - 1); const int lt = ltperm(it / 3), ha = (it % 3) * 8 + sub;
                            const bf16_t* up = U + (size_t)lt * LDU + 96 * ha + 12 * ll;
                            wa[b] = *(const GAS u32x4*)up; wb[b] = *(const GAS u32x2*)(up + 8); }
                        __builtin_amdgcn_sched_barrier(0);
#pragma unroll
                        for (int b = 0; b < NB; ++b) { const int it = it0 + b * NGW;
                            if (it < CH * 3) { const int lt = ltperm(it / 3), ha = (it % 3) * 8 + sub; const bool isq = ha < 12;
                                float x[12] = {bflo(wa[b].x), bfhi(wa[b].x), bflo(wa[b].y), bfhi(wa[b].y), bflo(wa[b].z), bfhi(wa[b].z), bflo(wa[b].w), bfhi(wa[b].w), bflo(wb[b].x), bfhi(wb[b].x), bflo(wb[b].y), bfhi(wb[b].y)};
                                float ss = 0.f;
#pragma unroll
                                for (int e2 = 0; e2 < 12; ++e2) ss += x[e2] * x[e2];
                                ss += shx<1>(ss); ss += shx<2>(ss); ss += shx<4>(ss);
                                const float rstd = rsqrtf(ss * (1.f / 96.f) + EPS);
                                const float scl = isq ? C2_96 : 1.0f;
                                const float fp = (float)(lt & (SL - 1));
#pragma unroll
                                for (int e2 = 0; e2 < 12; ++e2) { x[e2] = x[e2] * rstd * (isq ? gq[e2] : gk[e2]);
                                    const float pr = shx<1>(x[e2]);
                                    const float rev = __builtin_amdgcn_fractf(fp * ihi[e2]) + fp * ilo[e2];
                                    const float c1 = rot ? __builtin_amdgcn_cosf(rev) : 1.f, s1 = rot ? __builtin_amdgcn_sinf(rev) : 0.f;
                                    x[e2] = (x[e2] * c1 + (first ? -pr : pr) * s1) * scl; }
                                bf16_t* up = U + (size_t)lt * LDU + 96 * ha + 12 * ll;
                                u32x4 oa; oa.x = pk2(x[0], x[1]); oa.y = pk2(x[2], x[3]); oa.z = pk2(x[4], x[5]); oa.w = pk2(x[6], x[7]);
                                u32x2 ob; ob.x = pk2(x[8], x[9]); ob.y = pk2(x[10], x[11]);
                                *(GAS u32x4*)up = oa; *(GAS u32x2*)(up + 8) = ob; }
                            __builtin_amdgcn_sched_barrier(0); }
                    }
                }
                {
                    constexpr int NB = 8;
                    float g1[8], g3[8], bhi[8], blo[8], chi[8], clo[8];
#pragma unroll
                    for (int e2 = 0; e2 < 8; ++e2) { g1[e2] = kn_b[8 * ll + e2]; g3[e2] = kn_c[8 * ll + e2];
                        bhi[e2] = INVT[2 * (20 + 8 * (ll & 1) + e2)]; blo[e2] = INVT[2 * (20 + 8 * (ll & 1) + e2) + 1]; chi[e2] = INVT[2 * (12 + e2)]; clo[e2] = INVT[2 * (12 + e2) + 1]; }
                    for (int it0 = gw; it0 < CH * 2; it0 += NGW * NB) {
                        u32x4 wa[NB];
#pragma unroll
                        for (int b = 0; b < NB; ++b) { const int it = min(it0 + b * NGW, CH * 2 - 1); const int lt = ltperm(it >> 1), isBk = ((it & 1) == 0);
                            const bool active = !(isBk && sub < 6);
                            const int col = isBk ? (O_KB + 64 * ((sub < 6) ? 0 : (sub - 6))) : (O_KC + 64 * sub);
                            wa[b] = (u32x4){0u, 0u, 0u, 0u};
                            if (active) wa[b] = *(const GAS u32x4*)(U + (size_t)lt * LDU + col + 8 * ll); }
                        __builtin_amdgcn_sched_barrier(0);
#pragma unroll
                        for (int b = 0; b < NB; ++b) { const int it = it0 + b * NGW;
                            if (it < CH * 2) { const int lt = ltperm(it >> 1); const bool isB = ((it & 1) == 0);
                                const bool active = !(isB && sub < 6);
                                const int col = isB ? (O_KB + 64 * ((sub < 6) ? 0 : (sub - 6))) : (O_KC + 64 * sub);
                                float x[8] = {bflo(wa[b].x), bfhi(wa[b].x), bflo(wa[b].y), bfhi(wa[b].y), bflo(wa[b].z), bfhi(wa[b].z), bflo(wa[b].w), bfhi(wa[b].w)};
                                float ss = 0.f;
#pragma unroll
                                for (int e2 = 0; e2 < 8; ++e2) ss += x[e2] * x[e2];
                                ss += shx<1>(ss); ss += shx<2>(ss); ss += shx<4>(ss);
                                const float rstd = rsqrtf(ss * (1.f / 64.f) + EPS);
                                const int pos = lt & (SL - 1);
                                const float fp = (float)(isB ? ((ll < 4) ? (pos >> 6) : (pos & 63)) : pos);
                                const bool rot = isB ? true : (ll < 2);
                                const bool first = isB ? ((ll & 2) == 0) : (ll == 0);
#pragma unroll
                                for (int e2 = 0; e2 < 8; ++e2) { const float gsel = isB ? g1[e2] : g3[e2];
                                    x[e2] = x[e2] * rstd * gsel;
                                    const float p1 = shx<1>(x[e2]), p2 = shx<2>(x[e2]); const float pr = isB ? p2 : p1;
                                    const float rev = __builtin_amdgcn_fractf(fp * (isB ? bhi[e2] : chi[e2])) + fp * (isB ? blo[e2] : clo[e2]);
                                    const float c1 = rot ? __builtin_amdgcn_cosf(rev) : 1.f, s1 = rot ? __builtin_amdgcn_sinf(rev) : 0.f;
                                    x[e2] = x[e2] * c1 + (first ? -pr : pr) * s1; }
                                u32x4 oa; oa.x = pk2(x[0], x[1]); oa.y = pk2(x[2], x[3]); oa.z = pk2(x[4], x[5]); oa.w = pk2(x[6], x[7]);
                                if (active) *(GAS u32x4*)(U + (size_t)lt * LDU + col + 8 * ll) = oa; }
                            __builtin_amdgcn_sched_barrier(0); }
                    }
                }
                LAS bf16_t* scr = (LAS bf16_t*)(ldsl + wave * 13824);
                for (int rep = 0; rep < ((DUP & 512) ? 2 : 1); ++rep)
                for (int it = gw; it < 12 * 256; it += NGW) {
                    const int hv = it >> 8, blk = it & 255;
                    const int sl = (blk * 64) >> SLsh, p0 = (blk * 64) & (SL - 1);
                    const int dsh = 2 * (hv >> 2), Lsh = SLsh - dsh;
                    const size_t seqrow = (size_t)sl << SLsh;
#pragma unroll
                    for (int i2 = 0; i2 < 12; ++i2) { const int id = i2 * 64 + lane, pp = id / 12, ch = id % 12;
                        const int pcl = p0 + pp, c = pcl >> Lsh, i = pcl & ((1 << Lsh) - 1);
                        const u32x4 w = *(const u32x4*)(U + (seqrow + c + ((size_t)i << dsh)) * LDU + O_VA + 96 * hv + 8 * ch);
                        const int k15 = pp & 15, slot = (pp & ~15) | (k15 & 3) | ((k15 & 4) << 1) | ((k15 & 8) >> 1);
                        LAS bf16_t* d = scr + (8 * ch) * 72 + slot;
                        d[0 * 72] = (bf16_t)(w.x & 0xffff); d[1 * 72] = (bf16_t)(w.x >> 16); d[2 * 72] = (bf16_t)(w.y & 0xffff); d[3 * 72] = (bf16_t)(w.y >> 16);
                        d[4 * 72] = (bf16_t)(w.z & 0xffff); d[5 * 72] = (bf16_t)(w.z >> 16); d[6 * 72] = (bf16_t)(w.w & 0xffff); d[7 * 72] = (bf16_t)(w.w >> 16); }
                    LDS_WAIT(); asm volatile("" ::: "memory");
#pragma unroll
                    for (int i2 = 0; i2 < 12; ++i2) { const int id = i2 * 64 + lane, dv = id >> 3, pc = id & 7;
                        const u32x4 w = *(const LAS u32x4*)(scr + dv * 72 + 8 * pc);
                        const size_t blk32 = ((seqrow + p0) >> 5) + (pc >> 2); const int ks = (pc >> 1) & 1, hi2 = pc & 1;
                        *(GAS u32x4*)(VAT + ((((size_t)hv * (CH / 32) + blk32) * 2 + ks) * 3 + (dv >> 5)) * 512 + ((dv & 31) + 32 * hi2) * 8) = w; }
                    LDS_WAIT(); asm volatile("" ::: "memory");
                }
            }
            GSYNC();

            if (PH & 8) {
                PHASE_PTRS(); CHUNK_PTRS();
                const int nqb = SL >> 8, nseq = CH >> SLsh, NT = SL >> 6;
                const int nC = nseq * 8 * nqb, nB = nseq * 6 * nqb;
                const bool bal = (G == 256) && (nC == 512) && (nB == 384);
                const int lin = ((bx & 127) & 7) * 16 + ((bx & 127) >> 3);
                for (int rep = 0; rep < ((DUP & 8) ? 2 : 1); ++rep) if (PH & 128) {
                    const int cN = bal ? ((bx < 128) ? 3 : 1) : (nC - bx + G - 1) / G;
                    for (int i = 0; i < cN; ++i) {
                        const int un = bal ? ((bx < 128) ? (i * 128 + lin) : (384 + lin)) : (bx + i * G);
                        const int qb = un % nqb, r2 = un / nqb, sh = r2 & 7, sl = r2 >> 3;
                        const size_t seqrow = (size_t)sl << SLsh;
                        attn_body::attn_unit<4>(U + (seqrow + (size_t)qb * 256) * LDU + O_QC + 64 * sh, U + seqrow * LDU + O_KC + 64 * sh, U + seqrow * LDU + O_VC + 128 * (sh >> 1),
                                                OB + (seqrow + (size_t)qb * 256) * PO + 384 + 128 * sh, NT, (char*)lds, PIN(12) + l * 64, SC + 16, qb * 256);
                    }
                    const int bN = bal ? ((bx < 128) ? 0 : 3) : (nB - bx + G - 1) / G;
                    for (int i = 0; i < bN; ++i) {
                        const int un = bal ? (i * 128 + lin) : (bx + i * G);
                        const int qb = un % nqb, r2 = un / nqb, hu = r2 % 6, sl = r2 / 6;
                        const size_t seqrow = (size_t)sl << SLsh;
                        attn_body::attn_unit<2>(U + (seqrow + (size_t)qb * 256) * LDU + O_QB + 64 * hu, U + seqrow * LDU + O_KB + 64 * (hu / 3), U + seqrow * LDU + O_VB + 64 * (hu / 3),
                                                OB + (seqrow + (size_t)qb * 256) * PO + 64 * hu, NT, (char*)lds, PIN(10) + l * 64, SC + 16, qb * 256);
                    }
                }
                const float nb2 = SC[2 + l];
                const int r32 = lane & 31, hi = lane >> 5;
                const int per = SL >> 5;
                for (int rep = 0; rep < ((DUP & 4) ? 2 : 1); ++rep) {
                unsigned* actr = (unsigned*)(wsl + WS_BAR + 14336) + (rep * 6 + l * 3 + chunk) * 16;
                if (PH & 512) for (;;) {
                    volatile LAS int* slot = (volatile LAS int*)(ldsl + RING_BYTES + 64);
                    __syncthreads();
                    if (tid == 0) *slot = (int)__hip_atomic_fetch_add(actr, 1u, __ATOMIC_RELAXED, __HIP_MEMORY_SCOPE_AGENT);
                    __syncthreads();
                    const int bt = __builtin_amdgcn_readfirstlane(*slot);
                    if (bt * 8 >= (CH >> 5) * 12) break;
                    const int it = bt * 8 + wave;
                    const int ci = it % per; int rest = it / per;
                    const int j = rest & 3; rest >>= 2; const int g = rest % 3, sl = rest / 3;
                    const int dsh = 2 * g, Lsh = SLsh - dsh, L = 1 << Lsh, nbk = L >> 5;
                    const int c = ci / nbk, qb = ci % nbk, q0 = qb * 32, hv = g * 4 + j;
                    const size_t seqrow = (size_t)sl << SLsh;
                    const bf16_t* qp = U + (seqrow + c + ((size_t)(q0 + r32) << dsh)) * LDU + O_QA + hv * 96 + 8 * hi;
                    bf16x8 qr[6];
#pragma unroll
                    for (int d0 = 0; d0 < 6; ++d0) qr[d0] = *(const GAS bf16x8*)(qp + 16 * d0);
                    f32x16 o[3]; o[0] = f32x16{}; o[1] = f32x16{}; o[2] = f32x16{}; f32x16 ol = f32x16{};
                    const bf16x8 ones = {0x3F80, 0x3F80, 0x3F80, 0x3F80, 0x3F80, 0x3F80, 0x3F80, 0x3F80};
                    bf16x8 kf[2][6], vf[2][6];
#define A_LOAD(kb_, buf_) do { const int k0_ = q0 - 64 + 32 * (kb_); const int k0c_ = ((k0_ >= 0) && (k0_ < L)) ? k0_ : q0; \
                        const bf16_t* kp_ = U + (seqrow + c + ((size_t)(k0c_ + r32) << dsh)) * LDU + O_KA + hv * 96 + 8 * hi; \
                        const bf16_t* vp_ = VAT + (((size_t)hv * (CH / 32) + ((seqrow + ((size_t)c << Lsh) + k0c_) >> 5)) * 6) * 512 + lane * 8; \
                        _Pragma("unroll") for (int d0 = 0; d0 < 6; ++d0) kf[buf_][d0] = *(const GAS bf16x8*)(kp_ + 16 * d0); \
                        _Pragma("unroll") for (int ks = 0; ks < 2; ++ks) _Pragma("unroll") for (int dvb = 0; dvb < 3; ++dvb) vf[buf_][ks * 3 + dvb] = *(const GAS bf16x8*)(vp_ + (ks * 3 + dvb) * 512); } while (0)
                    A_LOAD(0, 0);
                    __builtin_amdgcn_sched_barrier(0);
#pragma unroll
                    for (int kb = 0; kb < 5; ++kb) {
                        if (kb < 4) { A_LOAD(kb + 1, (kb + 1) & 1); }
                        __builtin_amdgcn_sched_barrier(0);
                        const int k0 = q0 - 64 + 32 * kb; const bool inr = (k0 >= 0) && (k0 < L);
                        f32x16 s = f32x16{};
#pragma unroll
                        for (int d0 = 0; d0 < 6; ++d0) s = __builtin_amdgcn_mfma_f32_32x32x16_bf16(kf[kb & 1][d0], qr[d0], s, 0, 0, 0);
                        float pe[16];
#pragma unroll
                        for (int r = 0; r < 16; ++r) { const int kk = attn_body::crow(r, hi); bool valid = inr;
                            if (kb == 0) valid = valid && (kk >= r32);
                            if (kb == 4) valid = valid && (kk <= r32);
                            pe[r] = valid ? __builtin_amdgcn_exp2f(s[r] + nb2) : 0.f; }
#pragma unroll
                        for (int ks = 0; ks < 2; ++ks) {
                            u32x4 pw; pw.x = attn_body::cvtpk_s(pe[8 * ks + 0], pe[8 * ks + 1]); pw.y = attn_body::cvtpk_s(pe[8 * ks + 2], pe[8 * ks + 3]); pw.z = attn_body::cvtpk_s(pe[8 * ks + 4], pe[8 * ks + 5]); pw.w = attn_body::cvtpk_s(pe[8 * ks + 6], pe[8 * ks + 7]);
                            const bf16x8 pa = __builtin_bit_cast(bf16x8, pw);
#pragma unroll
                            for (int dvb = 0; dvb < 3; ++dvb) o[dvb] = __builtin_amdgcn_mfma_f32_32x32x16_bf16(pa, vf[kb & 1][ks * 3 + dvb], o[dvb], 0, 0, 0);
                            ol = __builtin_amdgcn_mfma_f32_32x32x16_bf16(pa, ones, ol, 0, 0, 0);
                        }
                        __builtin_amdgcn_sched_barrier(0);
                    }
#undef A_LOAD
                    {
                        int ln = lane; asm volatile("" : "+v"(ln));
                        const int r32s = ln & 31, his = ln >> 5;
                        LAS bf16_t* stg = (LAS bf16_t*)(ldsl + wave * 6400); LAS float* stl = (LAS float*)(ldsl + wave * 6400 + 6144);
#pragma unroll
                        for (int r = 0; r < 16; ++r) { const int orow = attn_body::crow(r, his);
                            stg[orow * 96 + r32s] = (bf16_t)f2bf(o[0][r]); stg[orow * 96 + 32 + r32s] = (bf16_t)f2bf(o[1][r]); stg[orow * 96 + 64 + r32s] = (bf16_t)f2bf(o[2][r]);
                            if (r32s == 0) stl[orow] = ol[r]; }
                        LDS_WAIT(); asm volatile("" ::: "memory");
#pragma unroll
                        for (int i2 = 0; i2 < 6; ++i2) { const int id = i2 * 64 + ln, row = id / 12, pc = id % 12;
                            const u32x4 w = *(const LAS u32x4*)(stg + id * 8);
                            const size_t trow = seqrow + c + ((size_t)(q0 + row) << dsh);
                            *(GAS u32x4*)(U + trow * LDU + O_VA + hv * 96 + 8 * pc) = w; }
                        if (ln < 32) { const size_t trow = seqrow + c + ((size_t)(q0 + ln) << dsh); *(GAS float*)(LA + trow * 12 + hv) = stl[ln]; }
                        LDS_WAIT(); asm volatile("" ::: "memory");
                    }
                }
                }
            }
            GSYNC();

            for (int rep = 0; rep < ((DUP & 16) ? 2 : 1); ++rep) if (PH & 16) {
                PHASE_PTRS(); CHUNK_PTRS();
                const float lam = SC[l];
                const float* subln = PIN(18) + l * 128;
                constexpr int NBP = 4;
                const int jA = lane >> 4, ddA = (lane & 15) * 6, idxB = lane * 6, hcC = lane >> 4, e0C = (lane & 15) * 8, vhC = e0C >> 6, ddC = e0C & 63;
                const f32x4 s0 = *(const f32x4*)(subln + e0C), s1 = *(const f32x4*)(subln + e0C + 4);
                for (int lt0 = gw; lt0 < CH; lt0 += NGW * NBP) {
                    unsigned qa[NBP][3][3], za[NBP][3], ob_[NBP][3], zb[NBP][3]; float la[NBP][3]; u32x4 ca[NBP], cb[NBP], zc[NBP];
#pragma unroll
                    for (int b = 0; b < NBP; ++b) { const int lt = min(lt0 + b * NGW, CH - 1);
                        const bf16_t* ur = U + (size_t)lt * LDU; const bf16_t* ob = OB + (size_t)lt * PO;
#pragma unroll
                        for (int g = 0; g < 3; ++g) { const GAS unsigned* q = (const GAS unsigned*)(ur + O_VA + (g * 4 + jA) * 96 + ddA); qa[b][g][0] = q[0]; qa[b][g][1] = q[1]; qa[b][g][2] = q[2];
                            la[b][g] = *(const GAS float*)(LA + (size_t)lt * 12 + g * 4 + jA); }
                        { const GAS unsigned* zq = (const GAS unsigned*)(ur + O_ZA + jA * 96 + ddA); za[b][0] = zq[0]; za[b][1] = zq[1]; za[b][2] = zq[2]; }
                        { const GAS unsigned* oq = (const GAS unsigned*)(ob + idxB); const GAS unsigned* zq = (const GAS unsigned*)(ur + O_ZB + idxB);
                          ob_[b][0] = oq[0]; ob_[b][1] = oq[1]; ob_[b][2] = oq[2]; zb[b][0] = zq[0]; zb[b][1] = zq[1]; zb[b][2] = zq[2]; }
                        ca[b] = *(const GAS u32x4*)(ob + 384 + ((2 * hcC) * 2 + vhC) * 64 + ddC); cb[b] = *(const GAS u32x4*)(ob + 384 + ((2 * hcC + 1) * 2 + vhC) * 64 + ddC);
                        zc[b] = *(const GAS u32x4*)(ur + O_ZC + hcC * 128 + e0C); }
                    __builtin_amdgcn_sched_barrier(0);
#pragma unroll
                    for (int b = 0; b < NBP; ++b) { const int lt = lt0 + b * NGW;
                        if (lt < CH) { bf16_t* y = Y + (size_t)lt * LDY;
                            {
                                float num[6] = {0.f, 0.f, 0.f, 0.f, 0.f, 0.f}; float den = 0.f;
#pragma unroll
                                for (int g = 0; g < 3; ++g) { num[0] += bflo(qa[b][g][0]); num[1] += bfhi(qa[b][g][0]); num[2] += bflo(qa[b][g][1]); num[3] += bfhi(qa[b][g][1]); num[4] += bflo(qa[b][g][2]); num[5] += bfhi(qa[b][g][2]); den += la[b][g]; }
                                const float rd = 1.0f / den; GAS unsigned* yo = (GAS unsigned*)(y + jA * 96 + ddA);
                                yo[0] = pk2(num[0] * rd * bflo(za[b][0]), num[1] * rd * bfhi(za[b][0])); yo[1] = pk2(num[2] * rd * bflo(za[b][1]), num[3] * rd * bfhi(za[b][1])); yo[2] = pk2(num[4] * rd * bflo(za[b][2]), num[5] * rd * bfhi(za[b][2])); }
                            {
                                GAS unsigned* yo = (GAS unsigned*)(y + 384 + idxB);
#pragma unroll
                                for (int e2 = 0; e2 < 3; ++e2) yo[e2] = pk2(bflo(ob_[b][e2]) * bflo(zb[b][e2]), bfhi(ob_[b][e2]) * bfhi(zb[b][e2])); }
                            {
                                const u32x4 a = ca[b], c2 = cb[b], z = zc[b];
                                float d[8] = {bflo(a.x) - lam * bflo(c2.x), bfhi(a.x) - lam * bfhi(c2.x), bflo(a.y) - lam * bflo(c2.y), bfhi(a.y) - lam * bfhi(c2.y),
                                              bflo(a.z) - lam * bflo(c2.z), bfhi(a.z) - lam * bfhi(c2.z), bflo(a.w) - lam * bflo(c2.w), bfhi(a.w) - lam * bfhi(c2.w)};
                                float ss = 0.f;
#pragma unroll
                                for (int e2 = 0; e2 < 8; ++e2) ss += d[e2] * d[e2];
                                const float rstd = rsqrtf(sum16(ss) * (1.f / 128.f) + EPS) * (1.0f - lam_init);
                                u32x4 w;
                                w.x = pk2(d[0] * rstd * s0.x * bflo(z.x), d[1] * rstd * s0.y * bfhi(z.x)); w.y = pk2(d[2] * rstd * s0.z * bflo(z.y), d[3] * rstd * s0.w * bfhi(z.y));
                                w.z = pk2(d[4] * rstd * s1.x * bflo(z.z), d[5] * rstd * s1.y * bfhi(z.z)); w.w = pk2(d[6] * rstd * s1.z * bflo(z.w), d[7] * rstd * s1.w * bfhi(z.w));
                                *(GAS u32x4*)(y + 768 + hcC * 128 + e0C) = w; }
                        }
                        __builtin_amdgcn_sched_barrier(0); }
                }
            }
            GSYNC();

            for (int rep = 0; rep < ((DUP & 32) ? 2 : 1); ++rep) if (PH & 32) {
                PHASE_PTRS(); CHUNK_PTRS();
                bf16_t* MG = H;
                const bf16_t* wo = WO + (size_t)l * 1024 * LDY;
                pg8::StaticOrder S; S.init(CH, DM, G, bx);
                { pg8::Gemm g{Y, wo, CH, DM, 384, LDY, LDY}; pg8::EpiMerge E{U + O_G, MG, 0}; pg8::gemm_phase<pg8::EpiMerge, true>(ldsl, g, S, E); }
                __syncthreads();
                { pg8::Gemm g{Y + 384, wo + 384, CH, DM, 384, LDY, LDY}; pg8::EpiMerge E{U + O_G + 1024, MG, 1}; pg8::gemm_phase<pg8::EpiMerge, true>(ldsl, g, S, E); }
                __syncthreads();
                { pg8::Gemm g{Y + 768, wo + 768, CH, DM, 512, LDY, LDY}; pg8::EpiMerge E{U + O_G + 2048, MG, 1}; pg8::gemm_phase<pg8::EpiMerge, true>(ldsl, g, S, E); }
            }
            GSYNC();

            for (int rep = 0; rep < (((DUP & 64) && l == 0) ? 2 : 1); ++rep) if (PH & 64) {
                PHASE_PTRS(); CHUNK_PTRS();
                pg8::Gemm g{H, WOUT + (size_t)l * 1024 * 1024, CH, DM, 1024, 1024, 1024};
                pg8::StaticOrder S; S.init(CH, DM, G, bx);
                pg8::EpiOut E{xin, xout, modl, chunk};
                pg8::gemm_phase<pg8::EpiOut, true>(ldsl, g, S, E);
            }
            if (!(l == 1 && chunk == NCHUNK - 1)) { const int nl = (chunk == NCHUNK - 1) ? l + 1 : l, nc = (chunk == NCHUNK - 1) ? 0 : chunk + 1; NORM_PHASE(nl, nc); }
            GSYNC();
        }
    }
}

extern "C" void kernel_launch(void* const* d_in, const int* in_sizes, int n_in, void* d_out, int out_size, void* d_ws, size_t ws_size, hipStream_t stream) {
    static int grid = 0;
    if (grid == 0) {
        if (n_in != 25 || ws_size < WS_END) { fprintf(stderr, "kernel_launch: unexpected n_in %d / ws %zu\n", n_in, ws_size); grid = -1; return; }
        int dev = 0, cus = 0, per_cu = 0;
        hipGetDevice(&dev); hipDeviceGetAttribute(&cus, hipDeviceAttributeMultiprocessorCount, dev);
        hipFuncSetAttribute((const void*)fwd_megakernel, hipFuncAttributeMaxDynamicSharedMemorySize, LDS_BYTES);
        hipOccupancyMaxActiveBlocksPerMultiprocessor(&per_cu, (const void*)fwd_megakernel, 512, LDS_BYTES);
        if (per_cu < 1) { fprintf(stderr, "kernel_launch: occupancy query says %d blocks per CU\n", per_cu); per_cu = 1; }
        grid = cus * 1;
        (void)hipGetLastError();
    }
    if (grid < 0) return;
    Params p{};
    for (int i = 0; i < 25; ++i) p.in[i] = (const float*)d_in[i];
    p.out = (float*)d_out; p.ws = (unsigned char*)d_ws;
    const double TWO_PI = 6.283185307179586476925286766559;
    for (int i = 0; i < 12; ++i) p.inv[i] = std::pow(500000.0, -(double)i / 12.0) / TWO_PI;
    for (int i = 0; i < 8; ++i) p.inv[12 + i] = std::pow(500000.0, -(double)i / 8.0) / TWO_PI;
    for (int i = 0; i < 16; ++i) p.inv[20 + i] = std::pow(10000.0, -(double)i / 16.0) / TWO_PI;
    void* args[] = {&p};
    hipError_t e = hipLaunchCooperativeKernel((const void*)fwd_megakernel, dim3(grid), dim3(512), args, LDS_BYTES, stream);
    if (e != hipSuccess) fprintf(stderr, "cooperative launch failed: %s (grid %d)\n", hipGetErrorString(e), grid);
}
```

```cpp
#include <hip/hip_runtime.h>
#include <hip/hip_cooperative_groups.h>
#include <cstdint>
#include <cstdio>
#include <cmath>
namespace cg = cooperative_groups;

#define LAS __attribute__((address_space(3)))
#define GAS __attribute__((address_space(1)))
typedef unsigned short bf16_t;
typedef short bf16x8 __attribute__((ext_vector_type(8)));
typedef short s16x4 __attribute__((ext_vector_type(4)));
typedef float f32x4 __attribute__((ext_vector_type(4)));
typedef float f32x16 __attribute__((ext_vector_type(16)));
typedef unsigned u32x4 __attribute__((ext_vector_type(4)));
typedef unsigned u32x2 __attribute__((ext_vector_type(2)));

constexpr int DM = 1024, TTOK = 49152, CH = 16384, NCHUNK = 3, NSEQ = 12;
constexpr int NIN = 9984;
constexpr int LDU = 8448;
constexpr int PO = 1408;
constexpr int LDY = 1280;
constexpr float EPS = 1e-6f;
constexpr float LOG2E = 1.4426950408889634f;
constexpr float C2_64 = 0.125f * LOG2E;
constexpr float C2_96 = 0.10206207261596577f * LOG2E;
constexpr int O_QA = 0, O_KA = 1152, O_VA = 2304, O_ZA = 3456, O_QB = 3840, O_KB = 4224, O_VB = 4352, O_ZB = 4480,
              O_QC = 4864, O_KC = 5376, O_VC = 5888, O_ZC = 6400, O_G = 6912;
constexpr size_t MiB = 1u << 20;
constexpr size_t WS_MOD = 0;
constexpr size_t WS_BAR = 576 * 1024;
constexpr size_t WS_SC = 512 * 1024;
constexpr size_t WS_TAB = 1 * MiB;
constexpr size_t WS_WIN = 8 * MiB;
constexpr size_t WS_WO = 48 * MiB;
constexpr size_t WS_WOUT = 54 * MiB;
constexpr size_t WS_H = 60 * MiB;
constexpr size_t WS_LA = 92 * MiB;
constexpr size_t WS_VAT = 94 * MiB;
constexpr size_t WS_OB = 134 * MiB;
constexpr size_t WS_U = 178 * MiB;
constexpr size_t WS_END = 490 * MiB;
constexpr int RING_BYTES = 131072, LDS_BYTES = RING_BYTES + 1024;

#ifndef PH
#define PH 0xFFF
#endif
#ifndef DUP
#define DUP 0
#endif
#define GSYNC() do { xcd_barrier(xbar); if (DUP & 256) xcd_barrier(xbar); } while (0)
struct Params { const float* in[25]; float* out; unsigned char* ws; double inv[36]; };

__device__ __forceinline__ unsigned f2bf(float f) { unsigned u = __builtin_bit_cast(unsigned, f); return (u + 0x7fffu + ((u >> 16) & 1u)) >> 16; }
__device__ __forceinline__ unsigned pk2(float lo, float hi) { return f2bf(lo) | (f2bf(hi) << 16); }
__device__ __forceinline__ float bflo(unsigned w) { return __builtin_bit_cast(float, w << 16); }
__device__ __forceinline__ float bfhi(unsigned w) { return __builtin_bit_cast(float, w & 0xffff0000u); }
__device__ __forceinline__ float sigmoidf_(float v) { return __builtin_amdgcn_rcpf(1.0f + __builtin_amdgcn_exp2f(-v * LOG2E)); }
__device__ __forceinline__ int opq_tid() { int t = threadIdx.x; asm volatile("" : "+v"(t)); return t; }
template <int X> __device__ __forceinline__ float shx(float v) {
    if constexpr (X < 32) return __builtin_bit_cast(float, __builtin_amdgcn_ds_swizzle(__builtin_bit_cast(int, v), (X << 10) | 0x1F));
    else return __builtin_bit_cast(float, __builtin_amdgcn_ds_bpermute((((opq_tid() & 63) ^ X) << 2), __builtin_bit_cast(int, v)));
}
__device__ __forceinline__ float sum16(float v) { v += shx<1>(v); v += shx<2>(v); v += shx<4>(v); v += shx<8>(v); return v; }
__device__ __forceinline__ float wave_sum(float v) { v = sum16(v); v += shx<16>(v); v += shx<32>(v); return v; }
__device__ __forceinline__ float wave_max(float v) { v = fmaxf(v, shx<1>(v)); v = fmaxf(v, shx<2>(v)); v = fmaxf(v, shx<4>(v)); v = fmaxf(v, shx<8>(v)); v = fmaxf(v, shx<16>(v)); v = fmaxf(v, shx<32>(v)); return v; }
#define LDS_WAIT() asm volatile("s_waitcnt lgkmcnt(0)" ::: "memory")
template <class T> __device__ __forceinline__ T* opq(T* p) { asm volatile("" : "+s"(p)); return (T*)(__attribute__((address_space(1))) T*)p; }

namespace pg8 {
constexpr int BM = 256, BK = 64, HALF = 128, HTB = HALF * BK * 2, STAGE_BYTES = 8 * HTB, NXCD = 8, WGM = 4;
__device__ __forceinline__ int lds_byte(int r, int c) { const int st = (r >> 4) * 2 + (c >> 5), rr = r & 15, cc = c & 31, ob = rr * 64 + cc * 2; return st * 1024 + (ob ^ (((ob >> 9) & 1) << 5)); }
__device__ __forceinline__ void stage_rc(int b, int& R, int& C) { const int st = b / 1024, sb = b % 1024, swz = sb ^ (((sb >> 9) & 1) << 5); R = (st >> 1) * 16 + swz / 64; C = (st & 1) * 32 + (swz % 64) / 2; }
__device__ __forceinline__ int perm32(int rho) { const int n = rho >> 4, i = rho & 15; return 8 * (i >> 2) + 4 * n + (i & 3); }
struct Unit { int pm, pn; };
struct Gemm { const bf16_t* A; const bf16_t* Bt; int M, N, K, lda, ldb; };
struct StaticOrder {
    int nM, nN, nwg, G, c;
    __device__ void init(int M, int N, int G_, int c_) { nM = M / BM; nN = N / BM; nwg = nM * nN; G = G_; c = c_; }
    __device__ bool next(int i, Unit& u) const {
        const long L = (long)i * G + c; if (L >= nwg) return false;
        int wgid = (int)L; { const int q = nwg / NXCD, r = nwg % NXCD, xcd = wgid % NXCD, off = wgid / NXCD; wgid = (xcd < r ? xcd * (q + 1) : r * (q + 1) + (xcd - r) * q) + off; }
        const int nig = WGM * nN, gid = wgid / nig, fm = gid * WGM, gsz = (nM - fm) < WGM ? (nM - fm) : WGM;
        u.pm = fm + ((wgid % nig) % gsz); u.pn = (wgid % nig) / gsz; return true;
    }
};
__device__ __forceinline__ unsigned cvt_pk_bf16(float lo, float hi) { unsigned r; asm volatile("v_cvt_pk_bf16_f32 %0, %1, %2" : "=v"(r) : "v"(lo), "v"(hi)); return r; }

template <class Epi, bool ALIGN_EPI>
__device__ __forceinline__ void gemm_phase(LAS unsigned char* lds, const Gemm g, const StaticOrder& S, const Epi& E) {
    const int tid = opq_tid(), wid = __builtin_amdgcn_readfirstlane(tid >> 6), lane = tid & 63, wr = wid >> 2, wc = wid & 3, fr = lane & 15, fq = lane >> 4;
    const int K = g.K, nt = K / BK;
    unsigned voffA[2], voffB[2];
#pragma unroll
    for (int i = 0; i < 2; ++i) { int R, C; stage_rc(tid * 16 + i * 8192, R, C); const int Rb = Epi::PERM ? ((R & ~31) + perm32(R & 31)) : R;
        voffA[i] = (unsigned)(R * g.lda + C) * 2u; voffB[i] = (unsigned)(Rb * g.ldb + C) * 2u; }
    const size_t kstep = (size_t)(BK * 2);
    const size_t hstepA = (size_t)HALF * g.lda * 2, hstepB = (size_t)HALF * g.ldb * 2;
    const size_t tstepA = 2 * hstepA, tstepB = 2 * hstepB;
    const unsigned ldsw = (unsigned)wid * 1024u;
    const int aoff = lds_byte(wr * 64 + fr, fq * 8), boff = lds_byte(wc * 32 + fr, fq * 8);
#define PG8_SA(b, h) (((b) * 2 + (h)) * HTB)
#define PG8_SB(b, h) ((4 + (b) * 2 + (h)) * HTB)
#define PG8_STAGE(bufoff, gbase, voff) do { _Pragma("unroll") for (int _i = 0; _i < 2; ++_i) \
        __builtin_amdgcn_global_load_lds((const unsigned*)((const char*)(gbase) + (voff)[_i]), (LAS unsigned*)(lds + (bufoff) + ldsw + _i * 8192), 16, 0, 0); } while (0)
#define PG8_LDA(dst, b, h) do { _Pragma("unroll") for (int m = 0; m < 4; ++m) _Pragma("unroll") for (int k = 0; k < 2; ++k) dst[m][k] = *(const LAS bf16x8*)(lds + PG8_SA(b, h) + aoff + m * 2048 + k * 1024); } while (0)
#define PG8_LDB(dst, b, h) do { _Pragma("unroll") for (int n = 0; n < 2; ++n) _Pragma("unroll") for (int k = 0; k < 2; ++k) dst[n][k] = *(const LAS bf16x8*)(lds + PG8_SB(b, h) + boff + n * 2048 + k * 1024); } while (0)
#define PG8_MMA(ai, bj, At, Bt) do { __builtin_amdgcn_s_setprio(1); _Pragma("unroll") for (int m = 0; m < 4; ++m) _Pragma("unroll") for (int n = 0; n < 2; ++n) _Pragma("unroll") for (int k = 0; k < 2; ++k) \
        acc[ai][bj][m][n] = __builtin_amdgcn_mfma_f32_16x16x32_bf16(Bt[n][k], At[m][k], acc[ai][bj][m][n], 0, 0, 0); __builtin_amdgcn_s_setprio(0); } while (0)
#define PG8_WAIT_V(n) asm volatile("s_waitcnt vmcnt(" #n ")" ::: "memory")
#define PG8_WAIT_L(n) asm volatile("s_waitcnt lgkmcnt(" #n ")" ::: "memory")
#define PG8_BAR __builtin_amdgcn_s_barrier()
#define PG8_SCHED __builtin_amdgcn_sched_barrier(0)
    Unit cur, nxt; int ui = 0;
    if (!S.next(0, cur)) return;
    f32x4 acc[2][2][4][2];
#pragma unroll
    for (int a = 0; a < 2; ++a)
#pragma unroll
        for (int b = 0; b < 2; ++b)
#pragma unroll
            for (int m = 0; m < 4; ++m)
#pragma unroll
                for (int n = 0; n < 2; ++n) acc[a][b][m][n] = (f32x4){0.f, 0.f, 0.f, 0.f};
    bf16x8 At[4][2], B0[2][2], B1[2][2];
    const char* cA = (const char*)g.A + (size_t)cur.pm * tstepA; const char* cB = (const char*)g.Bt + (size_t)cur.pn * tstepB;
    PG8_STAGE(PG8_SB(0, 0), cB, voffB); PG8_STAGE(PG8_SB(0, 1), cB + hstepB, voffB); PG8_STAGE(PG8_SA(0, 0), cA, voffA); PG8_STAGE(PG8_SA(0, 1), cA + hstepA, voffA);
    if (wr == 1) PG8_BAR;
    PG8_WAIT_V(2); PG8_BAR;
    PG8_STAGE(PG8_SB(1, 0), cB + kstep, voffB); PG8_STAGE(PG8_SA(1, 0), cA + kstep, voffA); PG8_STAGE(PG8_SB(1, 1), cB + hstepB + kstep, voffB);
    PG8_WAIT_V(6); PG8_BAR;
    for (;;) {
        const bool has_next = S.next(ui + 1, nxt);
        const char* nA = has_next ? (const char*)g.A + (size_t)nxt.pm * tstepA : cA; const char* nB = has_next ? (const char*)g.Bt + (size_t)nxt.pn * tstepB : cB;
#pragma unroll 1
        for (int t = 0; t < nt; t += 2) {
            const bool last = (t == nt - 2);
            const char* a1 = cA + (size_t)(t + 1) * kstep;
            const char* a2 = last ? nA : cA + (size_t)(t + 2) * kstep; const char* b2 = last ? nB : cB + (size_t)(t + 2) * kstep;
            const char* a3 = a2 + kstep; const char* b3 = b2 + kstep;
            PG8_LDB(B0, 0, 0); PG8_LDB(B1, 0, 1); PG8_SCHED; PG8_LDA(At, 0, 0); PG8_STAGE(PG8_SA(1, 1), a1 + hstepA, voffA);
            PG8_WAIT_V(8); PG8_WAIT_L(0); PG8_BAR; PG8_MMA(0, 0, At, B0); PG8_MMA(0, 1, At, B1); PG8_BAR; PG8_SCHED;
            PG8_LDA(At, 0, 1); PG8_STAGE(PG8_SB(0, 0), b2, voffB); PG8_STAGE(PG8_SB(0, 1), b2 + hstepB, voffB); PG8_STAGE(PG8_SA(0, 0), a2, voffA);
            PG8_WAIT_V(8); PG8_WAIT_L(0); PG8_BAR; PG8_MMA(1, 0, At, B0); PG8_MMA(1, 1, At, B1); PG8_BAR; PG8_SCHED;
            PG8_LDB(B0, 1, 0); PG8_LDB(B1, 1, 1); PG8_SCHED; PG8_LDA(At, 1, 0); PG8_STAGE(PG8_SA(0, 1), a2 + hstepA, voffA);
            PG8_WAIT_V(8); PG8_WAIT_L(0); PG8_BAR; PG8_MMA(0, 0, At, B0); PG8_MMA(0, 1, At, B1); PG8_BAR; PG8_SCHED;
            PG8_LDA(At, 1, 1); PG8_STAGE(PG8_SB(1, 0), b3, voffB); PG8_STAGE(PG8_SB(1, 1), b3 + hstepB, voffB); PG8_STAGE(PG8_SA(1, 0), a3, voffA);
            PG8_WAIT_V(8); PG8_WAIT_L(0); PG8_BAR; PG8_MMA(1, 0, At, B0); PG8_MMA(1, 1, At, B1); PG8_BAR; PG8_SCHED;
        }
        if constexpr (ALIGN_EPI) { if (wr == 0) PG8_BAR; }
        E(acc, cur, wr, wc, fr, fq);
        if (!has_next) break;
#pragma unroll
        for (int a = 0; a < 2; ++a)
#pragma unroll
            for (int b = 0; b < 2; ++b)
#pragma unroll
                for (int m = 0; m < 4; ++m)
#pragma unroll
                    for (int n = 0; n < 2; ++n) acc[a][b][m][n] = (f32x4){0.f, 0.f, 0.f, 0.f};
        cur = nxt; cA = nA; cB = nB; ++ui;
        if constexpr (ALIGN_EPI) { if (wr == 1) PG8_BAR; }
    }
    PG8_WAIT_V(0);
    if constexpr (!ALIGN_EPI) { if (wr == 0) PG8_BAR; }
    PG8_BAR;
#undef PG8_SA
#undef PG8_SB
#undef PG8_STAGE
#undef PG8_LDA
#undef PG8_LDB
#undef PG8_MMA
#undef PG8_WAIT_V
#undef PG8_WAIT_L
#undef PG8_BAR
#undef PG8_SCHED
}

struct EpiU {
    static constexpr bool PERM = true;
    bf16_t* U; const float* bbg;
    __device__ __forceinline__ void operator()(const f32x4 (&acc)[2][2][4][2], const Unit& u, int wr, int wc, int fr, int fq) const {
        const int row0 = u.pm * BM + wr * 64 + fr, colt = u.pn * BM;
        int mode[2]; f32x4 bv[2][2];
#pragma unroll
        for (int bj = 0; bj < 2; ++bj) { const int c0 = colt + bj * HALF + wc * 32 + 8 * fq;
            mode[bj] = (c0 >= O_G) ? 2 : (((c0 >= O_ZA && c0 < O_QB) || (c0 >= O_ZB && c0 < O_QC) || (c0 >= O_ZC)) ? 1 : 0);
            const int cb = (c0 >= O_G) ? (c0 - O_G) : 0;
            bv[bj][0] = *(const f32x4*)(bbg + cb); bv[bj][1] = *(const f32x4*)(bbg + cb + 4);
            if (mode[bj] != 2) { bv[bj][0] = (f32x4){0.f, 0.f, 0.f, 0.f}; bv[bj][1] = bv[bj][0]; } }
#pragma unroll
        for (int ai = 0; ai < 2; ++ai)
#pragma unroll
            for (int m = 0; m < 4; ++m) { bf16_t* rowp = U + (size_t)(row0 + ai * HALF + m * 16) * LDU + colt + wc * 32 + 8 * fq;
#pragma unroll
                for (int bj = 0; bj < 2; ++bj) { f32x4 v0 = acc[ai][bj][m][0] + bv[bj][0], v1 = acc[ai][bj][m][1] + bv[bj][1];
                    if (mode[bj] != 0) {
                        const bool z = (mode[bj] == 1);
#pragma unroll
                        for (int e = 0; e < 4; ++e) { const float s0 = sigmoidf_(v0[e]), s1 = sigmoidf_(v1[e]); v0[e] = z ? v0[e] * s0 : s0; v1[e] = z ? v1[e] * s1 : s1; }
                    }
                    if (mode[bj] == 2) {
                        unsigned char* gp8 = (unsigned char*)(U + (size_t)(row0 + ai * HALF + m * 16) * LDU + O_G) + (colt - O_G) + bj * HALF + wc * 32 + 8 * fq;
                        u32x2 w;
                        w.x = (unsigned)(v0[0] * 255.f + 0.5f) | ((unsigned)(v0[1] * 255.f + 0.5f) << 8) | ((unsigned)(v0[2] * 255.f + 0.5f) << 16) | ((unsigned)(v0[3] * 255.f + 0.5f) << 24);
                        w.y = (unsigned)(v1[0] * 255.f + 0.5f) | ((unsigned)(v1[1] * 255.f + 0.5f) << 8) | ((unsigned)(v1[2] * 255.f + 0.5f) << 16) | ((unsigned)(v1[3] * 255.f + 0.5f) << 24);
                        *(u32x2*)gp8 = w;
                    } else {
                    u32x4 w; w.x = cvt_pk_bf16(v0[0], v0[1]); w.y = cvt_pk_bf16(v0[2], v0[3]); w.z = cvt_pk_bf16(v1[0], v1[1]); w.w = cvt_pk_bf16(v1[2], v1[3]);
                    *(u32x4*)(rowp + bj * HALF) = w; } } }
    }
};
struct EpiMerge {
    static constexpr bool PERM = true;
    const unsigned char* G; bf16_t* Mg; int accum;
    __device__ __forceinline__ void operator()(const f32x4 (&acc)[2][2][4][2], const Unit& u, int wr, int wc, int fr, int fq) const {
        const int row0 = u.pm * BM + wr * 64 + fr, col0 = u.pn * BM + wc * 32 + 8 * fq;
        const unsigned char* gp = G + (size_t)row0 * (2 * LDU) + col0; bf16_t* mp = Mg + (size_t)row0 * DM + col0;
        constexpr float K255 = 1.0f / 255.0f;
#pragma unroll
        for (int ai = 0; ai < 2; ++ai) {
            u32x2 gw[4][2]; u32x4 ow[4][2];
#pragma unroll
            for (int m = 0; m < 4; ++m)
#pragma unroll
                for (int bj = 0; bj < 2; ++bj) { gw[m][bj] = *(const GAS u32x2*)(gp + (size_t)m * 16 * (2 * LDU) + bj * HALF);
                    ow[m][bj] = accum ? *(const GAS u32x4*)(mp + (size_t)m * 16 * DM + bj * HALF) : (u32x4){0u, 0u, 0u, 0u}; }
            __builtin_amdgcn_sched_barrier(0);
#pragma unroll
            for (int m = 0; m < 4; ++m)
#pragma unroll
                for (int bj = 0; bj < 2; ++bj) {
                    f32x4 v0 = acc[ai][bj][m][0], v1 = acc[ai][bj][m][1]; const u32x2 g2 = gw[m][bj]; const u32x4 o4 = ow[m][bj];
#define GB(w_, i_) ((float)(((w_) >> (8 * (i_))) & 255u) * K255)
                    v0[0] = v0[0] * GB(g2.x, 0) + bflo(o4.x); v0[1] = v0[1] * GB(g2.x, 1) + bfhi(o4.x); v0[2] = v0[2] * GB(g2.x, 2) + bflo(o4.y); v0[3] = v0[3] * GB(g2.x, 3) + bfhi(o4.y);
                    v1[0] = v1[0] * GB(g2.y, 0) + bflo(o4.z); v1[1] = v1[1] * GB(g2.y, 1) + bfhi(o4.z); v1[2] = v1[2] * GB(g2.y, 2) + bflo(o4.w); v1[3] = v1[3] * GB(g2.y, 3) + bfhi(o4.w);
#undef GB
                    u32x4 w; w.x = cvt_pk_bf16(v0[0], v0[1]); w.y = cvt_pk_bf16(v0[2], v0[3]); w.z = cvt_pk_bf16(v1[0], v1[1]); w.w = cvt_pk_bf16(v1[2], v1[3]);
                    *(GAS u32x4*)(mp + (size_t)m * 16 * DM + bj * HALF) = w; }
            gp += 128 * (2 * LDU); mp += 128 * DM;
            asm volatile("" : "+v"(gp), "+v"(mp) :: "memory"); }
    }
};
struct EpiOut {
    static constexpr bool PERM = false;
    const float* xin; float* out; const float* modl; int chunk;
    __device__ __forceinline__ void operator()(const f32x4 (&acc)[2][2][4][2], const Unit& u, int wr, int wc, int fr, int fq) const {
        const int rowt = u.pm * BM; const int s = (chunk == 0) ? (rowt >> 11) : (8 + 2 * (chunk - 1) + (rowt >> 13));
        const float* gp = modl + (size_t)s * 3072 + 2048;
        const int row0 = rowt + wr * 64 + fr, col0 = u.pn * BM + wc * 32 + 4 * fq;
        f32x4 gv[2][2];
#pragma unroll
        for (int bj = 0; bj < 2; ++bj)
#pragma unroll
            for (int n = 0; n < 2; ++n) gv[bj][n] = *(const f32x4*)(gp + col0 + bj * HALF + n * 16);
#pragma unroll
        for (int ai = 0; ai < 2; ++ai) {
            f32x4 xb[4][2][2];
#pragma unroll
            for (int m = 0; m < 4; ++m) { const size_t off = (size_t)(row0 + ai * HALF + m * 16) * DM + col0;
#pragma unroll
                for (int bj = 0; bj < 2; ++bj)
#pragma unroll
                    for (int n = 0; n < 2; ++n) xb[m][bj][n] = *(const GAS f32x4*)(xin + off + bj * HALF + n * 16); }
            __builtin_amdgcn_sched_barrier(0);
#pragma unroll
            for (int m = 0; m < 4; ++m) { const size_t off = (size_t)(row0 + ai * HALF + m * 16) * DM + col0;
#pragma unroll
                for (int bj = 0; bj < 2; ++bj)
#pragma unroll
                    for (int n = 0; n < 2; ++n) *(GAS f32x4*)(out + off + bj * HALF + n * 16) = xb[m][bj][n] + gv[bj][n] * acc[ai][bj][m][n]; }
            __builtin_amdgcn_sched_barrier(0); }
    }
};
}

namespace attn_body {
constexpr int D = 64, NW = 8, QBLK = 32, QB = QBLK * NW, KVBLK = 64;
constexpr int PU = LDU;
__device__ __forceinline__ int crow(int r, int hi) { return (r & 3) + 8 * (r >> 2) + 4 * hi; }
#define SBAR() __builtin_amdgcn_sched_barrier(0)
constexpr int NSLOT = 3, SLOTB = 8192;
constexpr int LDS_K = 0, LDS_V = NSLOT * SLOTB, LDS_WS = 2 * NSLOT * SLOTB, LDS_OST = LDS_WS + NW * 64 * 4, LDS_BYTES_A = LDS_OST + NW * 4096;
__device__ __forceinline__ void glds16(const void* gsrc, unsigned lds_dst) { unsigned keep;
  asm volatile("s_mov_b32 %0, m0\n\ts_mov_b32 m0, %2\n\ts_nop 0\n\tglobal_load_lds_dwordx4 %1, off\n\ts_mov_b32 m0, %0" : "=&s"(keep) : "v"(gsrc), "s"(lds_dst) : "memory"); }
__device__ __forceinline__ float max3f(float a, float b, float c) { float r; asm("v_max3_f32 %0, %1, %2, %3" : "=v"(r) : "v"(a), "v"(b), "v"(c)); return r; }
__device__ __forceinline__ float max2f(float a, float b) { float r; asm("v_max_f32_e32 %0, %1, %2" : "=v"(r) : "v"(a), "v"(b)); return r; }
__device__ __forceinline__ float fadd_s(float a, float b) { float r; asm("v_add_f32_e32 %0, %1, %2" : "=v"(r) : "v"(a), "v"(b)); return r; }
__device__ __forceinline__ float fsub_s(float a, float b) { float r; asm("v_sub_f32_e32 %0, %1, %2" : "=v"(r) : "v"(a), "v"(b)); return r; }
typedef float f32x2_t __attribute__((ext_vector_type(2))); typedef __bf16 bf16x2_t __attribute__((ext_vector_type(2)));
__device__ __forceinline__ unsigned cvtpk_s(float lo, float hi) { f32x2_t v = {lo, hi}; bf16x2_t b = __builtin_convertvector(v, bf16x2_t); return __builtin_bit_cast(unsigned, b); }
#define WAIT_BAR(N) asm volatile("s_waitcnt vmcnt(" #N ") lgkmcnt(0)\n\ts_barrier" ::: "memory")
__device__ __forceinline__ void qkt(f32x16& p0, f32x16& p1, const char* Kslot, const bf16x8* qr, const f32x16& negm, int r32, int hi) {
  const char* kb = Kslot + hi * 1024 + r32 * 16;
  #pragma unroll
  for (int d0 = 0; d0 < 4; ++d0) {
    const bf16x8 b0 = *reinterpret_cast<const bf16x8*>(kb + d0 * 2048);
    const bf16x8 b1 = *reinterpret_cast<const bf16x8*>(kb + d0 * 2048 + 512);
    if (d0 == 0) { p0 = __builtin_amdgcn_mfma_f32_32x32x16_bf16(b0, qr[0], negm, 0, 0, 0); p1 = __builtin_amdgcn_mfma_f32_32x32x16_bf16(b1, qr[0], negm, 0, 0, 0); }
    else { p0 = __builtin_amdgcn_mfma_f32_32x32x16_bf16(b0, qr[d0], p0, 0, 0, 0); p1 = __builtin_amdgcn_mfma_f32_32x32x16_bf16(b1, qr[d0], p1, 0, 0, 0); } }
}
typedef __attribute__((address_space(3))) const char* lds_cptr;
typedef short v4i16_t __attribute__((ext_vector_type(4)));
__device__ __forceinline__ void kload8(bf16x8* kf, lds_cptr kp) {
  kf[0] = *(const __attribute__((address_space(3))) bf16x8*)(kp);        kf[1] = *(const __attribute__((address_space(3))) bf16x8*)(kp + 512);
  kf[2] = *(const __attribute__((address_space(3))) bf16x8*)(kp + 2048); kf[3] = *(const __attribute__((address_space(3))) bf16x8*)(kp + 2560);
  kf[4] = *(const __attribute__((address_space(3))) bf16x8*)(kp + 4096); kf[5] = *(const __attribute__((address_space(3))) bf16x8*)(kp + 4608);
  kf[6] = *(const __attribute__((address_space(3))) bf16x8*)(kp + 6144); kf[7] = *(const __attribute__((address_space(3))) bf16x8*)(kp + 6656);
}
__device__ __forceinline__ void kload2(bf16x8* kf, lds_cptr kp, int j) { kf[2 * j] = *(const __attribute__((address_space(3))) bf16x8*)(kp + j * 2048); kf[2 * j + 1] = *(const __attribute__((address_space(3))) bf16x8*)(kp + j * 2048 + 512); }
__device__ __forceinline__ s16x4 vtr(lds_cptr p) { return __builtin_bit_cast(s16x4, __builtin_amdgcn_ds_read_tr16_b64_v4i16((__attribute__((address_space(3))) v4i16_t*)p)); }
__device__ __forceinline__ float rowmax(const f32x16& p0, const f32x16& p1) {
  float a = max3f(p0[0], p0[1], p1[0]), b = max3f(p0[2], p0[3], p1[1]); a = max3f(a, p1[2], p1[3]);
  #pragma unroll
  for (int r = 4; r < 16; r += 4) { a = max3f(a, p0[r], p0[r + 1]); b = max3f(b, p0[r + 2], p0[r + 3]); a = max3f(a, p1[r], p1[r + 1]); b = max3f(b, p1[r + 2], p1[r + 3]); }
  const float m = max2f(a, b);
  auto rr = __builtin_amdgcn_permlane32_swap(__float_as_uint(m), __float_as_uint(m), false, false);
  return max2f(__uint_as_float(rr[0]), __uint_as_float(rr[1]));
}
__device__ __forceinline__ void pv(f32x16* o, int vb, bf16x8 pa0, bf16x8 pa1, bf16x8 pa2, bf16x8 pa3) {
  #pragma unroll
  for (int d0 = 0; d0 < 2; ++d0) { s16x4 lo[4], hi[4];
    #pragma unroll
    for (int ks = 0; ks < 4; ++ks) {
      asm volatile("ds_read_b64_tr_b16 %0,%1 offset:%c2" : "=&v"(lo[ks]) : "v"(vb), "i"(d0 * 4096 + ks * 1024) : "memory");
      asm volatile("ds_read_b64_tr_b16 %0,%1 offset:%c2" : "=&v"(hi[ks]) : "v"(vb), "i"(d0 * 4096 + ks * 1024 + 512) : "memory"); }
    asm volatile("s_waitcnt lgkmcnt(0)" ::: "memory"); SBAR();
    #define PK(k) (bf16x8){lo[k][0], lo[k][1], lo[k][2], lo[k][3], hi[k][0], hi[k][1], hi[k][2], hi[k][3]}
    o[d0] = __builtin_amdgcn_mfma_f32_32x32x16_bf16(pa0, PK(0), o[d0], 0, 0, 0);
    o[d0] = __builtin_amdgcn_mfma_f32_32x32x16_bf16(pa1, PK(1), o[d0], 0, 0, 0);
    o[d0] = __builtin_amdgcn_mfma_f32_32x32x16_bf16(pa2, PK(2), o[d0], 0, 0, 0);
    o[d0] = __builtin_amdgcn_mfma_f32_32x32x16_bf16(pa3, PK(3), o[d0], 0, 0, 0);
    #undef PK
  }
}
template <int NDV> __device__ __forceinline__ void pvn(f32x16* o, int vb, bf16x8 pa0, bf16x8 pa1, bf16x8 pa2, bf16x8 pa3) {
  #pragma unroll
  for (int d0 = 0; d0 < NDV; ++d0) { s16x4 lo[4], hi[4];
    #pragma unroll
    for (int ks = 0; ks < 4; ++ks) {
      asm volatile("ds_read_b64_tr_b16 %0,%1 offset:%c2" : "=&v"(lo[ks]) : "v"(vb), "i"(d0 * 4096 + ks * 1024) : "memory");
      asm volatile("ds_read_b64_tr_b16 %0,%1 offset:%c2" : "=&v"(hi[ks]) : "v"(vb), "i"(d0 * 4096 + ks * 1024 + 512) : "memory"); }
    asm volatile("s_waitcnt lgkmcnt(0)" ::: "memory"); SBAR();
    #define PK(k) (bf16x8){lo[k][0], lo[k][1], lo[k][2], lo[k][3], hi[k][0], hi[k][1], hi[k][2], hi[k][3]}
    o[d0] = __builtin_amdgcn_mfma_f32_32x32x16_bf16(pa0, PK(0), o[d0], 0, 0, 0);
    o[d0] = __builtin_amdgcn_mfma_f32_32x32x16_bf16(pa1, PK(1), o[d0], 0, 0, 0);
    o[d0] = __builtin_amdgcn_mfma_f32_32x32x16_bf16(pa2, PK(2), o[d0], 0, 0, 0);
    o[d0] = __builtin_amdgcn_mfma_f32_32x32x16_bf16(pa3, PK(3), o[d0], 0, 0, 0);
    #undef PK
  }
}
template <int NDV> __device__ __forceinline__ void attn_unit(const bf16_t* Qu, const bf16_t* __restrict__ Kh, const bf16_t* __restrict__ Vh, bf16_t* Ou, const int NT, char* shm, const float* gq, const float* invt, const int pos0) {
  constexpr int NV = NDV / 2, VSLOT = 4096 * NDV;
  constexpr int L_K = 0, L_V = 3 * 8192, L_WS = L_V + 3 * VSLOT, L_OST = L_WS + NW * 64 * 4;
  const int tid = opq_tid(), lane = tid & 63, r32 = lane & 31, hi = lane >> 5; const int wid = __builtin_amdgcn_readfirstlane(tid >> 6);
  const bf16_t* Qw = Qu + (long)(wid * QBLK) * PU;
  const unsigned lds0 = (unsigned)(uintptr_t)shm;
  float* wsf = (float*)(shm + L_WS) + wid * 64;
  const bf16_t* ksrc = Kh + (long)lane * PU + wid * 8;
  const bf16_t* vsrc = Vh + (long)(16 * (wid & 3) + (lane >> 2)) * PU + (wid >> 2) * 32 + (lane & 3) * 8;
  const unsigned kdst = lds0 + L_K + wid * 1024, vdst = lds0 + L_V + wid * 1024;
  #define DMA_K(t, si) glds16(ksrc + (long)(t) * KVBLK * PU, (unsigned)__builtin_amdgcn_readfirstlane(kdst + (si) * 8192))
  #define DMA_V(t, si) do { glds16(vsrc + (long)(t) * KVBLK * PU, (unsigned)__builtin_amdgcn_readfirstlane(vdst + (si) * VSLOT)); \
      if (NV == 2) glds16(vsrc + 64 + (long)(t) * KVBLK * PU, (unsigned)__builtin_amdgcn_readfirstlane(vdst + (si) * VSLOT + 8192)); } while (0)
  const int vb0 = (int)(lds0 + L_V) + ((lane >> 4) & 1) * 32 + (lane & 3) * 8 + (4 * hi + ((lane & 15) >> 2)) * 64;
  const char* Kbase = shm + L_K; bf16x8 kf[8];
  const lds_cptr shm3 = (lds_cptr)shm; const lds_cptr kp0 = shm3 + L_K + hi * 1024 + r32 * 16; const lds_cptr vp0 = shm3 + L_V + ((lane >> 4) & 1) * 32 + (lane & 3) * 8 + (4 * hi + ((lane & 15) >> 2)) * 64;
  DMA_K(0, 0); DMA_V(0, 0); DMA_K(1, 1);
  bf16x8 qr[4];
  { bf16x8 qraw[4];
    #pragma unroll
    for (int d0 = 0; d0 < 4; ++d0) qraw[d0] = *reinterpret_cast<const bf16x8*>(&Qw[(long)r32 * PU + d0 * 16 + hi * 8]);
    float x[4][8]; float ss = 0.f;
    #pragma unroll
    for (int d0 = 0; d0 < 4; ++d0)
      #pragma unroll
      for (int j = 0; j < 8; ++j) { x[d0][j] = __builtin_bit_cast(float, (unsigned)(unsigned short)qraw[d0][j] << 16); ss += x[d0][j] * x[d0][j]; }
    ss += shx<32>(ss);
    const float rstd = rsqrtf(ss * (1.f / 64.f) + EPS);
    #pragma unroll
    for (int d0 = 0; d0 < 4; ++d0) { const f32x4 ga = *(const f32x4*)(gq + 16 * d0 + 8 * hi), gb = *(const f32x4*)(gq + 16 * d0 + 8 * hi + 4);
      x[d0][0] *= rstd * ga.x; x[d0][1] *= rstd * ga.y; x[d0][2] *= rstd * ga.z; x[d0][3] *= rstd * ga.w; x[d0][4] *= rstd * gb.x; x[d0][5] *= rstd * gb.y; x[d0][6] *= rstd * gb.z; x[d0][7] *= rstd * gb.w; }
    const int pos = pos0 + wid * QBLK + r32;
    if (NDV == 2) {
      const float fr = (float)(pos >> 6), fc = (float)(pos & 63);
      #pragma unroll
      for (int j = 0; j < 8; ++j) { const float ih = invt[2 * (20 + 8 * hi + j)], il = invt[2 * (20 + 8 * hi + j) + 1];
        const float rr = __builtin_amdgcn_fractf(fr * ih) + fr * il, rc = __builtin_amdgcn_fractf(fc * ih) + fc * il;
        const float c1 = __builtin_amdgcn_cosf(rr), s1 = __builtin_amdgcn_sinf(rr), c2 = __builtin_amdgcn_cosf(rc), s2 = __builtin_amdgcn_sinf(rc);
        const float a = x[0][j], b = x[1][j], c = x[2][j], d = x[3][j];
        x[0][j] = a * c1 - b * s1; x[1][j] = b * c1 + a * s1; x[2][j] = c * c2 - d * s2; x[3][j] = d * c2 + c * s2; }
    } else {
      const float fp = (float)pos;
      #pragma unroll
      for (int j = 0; j < 8; ++j) { const float ih = invt[2 * (12 + j)], il = invt[2 * (12 + j) + 1];
        const float rv = __builtin_amdgcn_fractf(fp * ih) + fp * il; const float c1 = __builtin_amdgcn_cosf(rv), s1 = __builtin_amdgcn_sinf(rv);
        const float pr = shx<32>(x[0][j]);
        x[0][j] = x[0][j] * c1 + ((hi == 0) ? -pr : pr) * s1; }
    }
    #pragma unroll
    for (int d0 = 0; d0 < 4; ++d0) { u32x4 w; w.x = cvtpk_s(x[d0][0] * C2_64, x[d0][1] * C2_64); w.y = cvtpk_s(x[d0][2] * C2_64, x[d0][3] * C2_64); w.z = cvtpk_s(x[d0][4] * C2_64, x[d0][5] * C2_64); w.w = cvtpk_s(x[d0][6] * C2_64, x[d0][7] * C2_64);
      qr[d0] = __builtin_bit_cast(bf16x8, w); } }
  float l_reg = 0.f; f32x16 o[NDV];
  #pragma unroll
  for (int d0 = 0; d0 < NDV; ++d0) o[d0] = f32x16{};
  const f32x16 zero16 = f32x16{};
  f32x16 pA0, pA1, pB0, pB1;
  int i_prev = 0, i_cur = 0, i_next = 1;
  #define ROT() do { i_prev = i_cur; i_cur = i_next; i_next = (i_next == 2) ? 0 : i_next + 1; } while (0)
  #define WAIT_STEADY() do { if (NV == 1) { WAIT_BAR(2); } else { WAIT_BAR(3); } } while (0)
  #define WAIT_VONLY() do { if (NV == 1) { WAIT_BAR(1); } else { WAIT_BAR(2); } } while (0)
  DMA_K(2, 2);
  if (NV == 1) { WAIT_BAR(3); } else { WAIT_BAR(4); }
  qkt(pA0, pA1, Kbase, qr, zero16, r32, hi);
  _Pragma("unroll") for (int r = 0; r < 16; ++r) { pA0[r] = __builtin_amdgcn_exp2f(pA0[r]); pA1[r] = __builtin_amdgcn_exp2f(pA1[r]); }
  WAIT_BAR(0);
  DMA_K(3, 0); DMA_V(1, 1);
  ROT();
  kload8(kf, kp0 + i_cur * 8192);
  WAIT_STEADY();
  s16x4 vlo[8], vhi[8]; u32x4 pw0, pw1, pw2, pw3;
  #define PKW(P, B) cvtpk_s(P[B], P[B + 1])
  #define PAF(k) __builtin_bit_cast(bf16x8, pw##k)
  #define VFR(i) (bf16x8){vlo[i][0], vlo[i][1], vlo[i][2], vlo[i][3], vhi[i][0], vhi[i][1], vhi[i][2], vhi[i][3]}
  #define PIN(x) asm volatile("" : "+v"(x))
  #define GAPA(MF, A0, A1, A2, A3, W0, W1, PW) do { MF; sacc += A0; sacc += A1; sacc += A2; sacc += A3; PIN(sacc); W0; W1; PIN(PW); SBAR(); } while (0)
  #define EX(v) __builtin_amdgcn_exp2f(v)
  #define GAPB(MF, X, B) do { MF; X[B] = EX(X[B]); X[B + 1] = EX(X[B + 1]); X[B + 2] = EX(X[B + 2]); X[B + 3] = EX(X[B + 3]); PIN(X); SBAR(); } while (0)
  #define GAPB2(MF, X, B) do { MF; X[B] = EX(X[B]); X[B + 1] = EX(X[B + 1]); PIN(X); SBAR(); } while (0)
  #define VRD(i) do { vlo[i] = vtr(vp_ + (((i) >> 2) * 4096 + ((i) & 3) * 1024)); vhi[i] = vtr(vp_ + (((i) >> 2) * 4096 + ((i) & 3) * 1024 + 512)); } while (0)
  #define VRD2(i) do { vlo[i] = vtr(vp_ + ((((i) >> 2) + 2) * 4096 + ((i) & 3) * 1024)); vhi[i] = vtr(vp_ + ((((i) >> 2) + 2) * 4096 + ((i) & 3) * 1024 + 512)); SBAR(); } while (0)
  #define KRD(G, j) do { if (G) { kload2(kf, kp0 + i_next * 8192, j); SBAR(); } } while (0)
  #define MFO(d, k, v) o[d] = __builtin_amdgcn_mfma_f32_32x32x16_bf16(PAF(k), VFR(v), o[d], 0, 0, 0)
  #define STEP(C0, C1, P0, P1, t, GK, GV, GL) do { SBAR(); \
    const lds_cptr vp_ = vp0 + i_prev * VSLOT; \
    VRD(0); SBAR(); float sacc = (P0[0] + P0[1]); \
    GAPA(C0 = __builtin_amdgcn_mfma_f32_32x32x16_bf16(kf[0], qr[0], zero16, 0, 0, 0), P0[2], P0[3], P0[4], P0[5],     pw0[0] = PKW(P0, 0), pw0[1] = PKW(P0, 2), pw0); \
    VRD(4); SBAR(); GAPA(C1 = __builtin_amdgcn_mfma_f32_32x32x16_bf16(kf[1], qr[0], zero16, 0, 0, 0), P0[6], P0[7], P0[8], P0[9],     pw0[2] = PKW(P0, 4), pw0[3] = PKW(P0, 6), pw0); \
    VRD(1); SBAR(); GAPA(C0 = __builtin_amdgcn_mfma_f32_32x32x16_bf16(kf[2], qr[1], C0, 0, 0, 0),   P0[10], P0[11], P0[12], P0[13], pw1[0] = PKW(P0, 8), pw1[1] = PKW(P0, 10), pw1); \
    VRD(5); SBAR(); GAPA(C1 = __builtin_amdgcn_mfma_f32_32x32x16_bf16(kf[3], qr[1], C1, 0, 0, 0),   P0[14], P0[15], P1[0], P1[1],   pw1[2] = PKW(P0, 12), pw1[3] = PKW(P0, 14), pw1); \
    VRD(2); SBAR(); GAPA(C0 = __builtin_amdgcn_mfma_f32_32x32x16_bf16(kf[4], qr[2], C0, 0, 0, 0),   P1[2], P1[3], P1[4], P1[5],     pw2[0] = PKW(P1, 0), pw2[1] = PKW(P1, 2), pw2); \
    VRD(6); SBAR(); GAPA(C1 = __builtin_amdgcn_mfma_f32_32x32x16_bf16(kf[5], qr[2], C1, 0, 0, 0),   P1[6], P1[7], P1[8], P1[9],     pw2[2] = PKW(P1, 4), pw2[3] = PKW(P1, 6), pw2); \
    VRD(3); SBAR(); GAPA(C0 = __builtin_amdgcn_mfma_f32_32x32x16_bf16(kf[6], qr[3], C0, 0, 0, 0),   P1[10], P1[11], P1[12], P1[13], pw3[0] = PKW(P1, 8), pw3[1] = PKW(P1, 10), pw3); \
    VRD(7); SBAR(); GAPA(C1 = __builtin_amdgcn_mfma_f32_32x32x16_bf16(kf[7], qr[3], C1, 0, 0, 0),   P1[14], P1[15], 0.f, 0.f,       pw3[2] = PKW(P1, 12), pw3[3] = PKW(P1, 14), pw3); \
    l_reg += sacc; \
    if (GK) { DMA_K((t) + 3, i_cur); } if (GV) { DMA_V((t) + 1, i_next); } \
    SBAR(); \
    if (NDV == 2) { \
      GAPB(MFO(0, 0, 0), C0, 0); \
      GAPB(MFO(1, 0, 4), C0, 4); \
      KRD(GL, 0); GAPB(MFO(0, 1, 1), C0, 8); \
      KRD(GL, 1); GAPB(MFO(1, 1, 5), C0, 12); \
      KRD(GL, 2); GAPB(MFO(0, 2, 2), C1, 0); \
      KRD(GL, 3); GAPB(MFO(1, 2, 6), C1, 4); \
      GAPB(MFO(0, 3, 3), C1, 8); \
      GAPB(MFO(1, 3, 7), C1, 12); \
    } else { \
      GAPB2(MFO(0, 0, 0), C0, 0); VRD2(0); \
      GAPB2(MFO(1, 0, 4), C0, 2); VRD2(4); \
      KRD(GL, 0); GAPB2(MFO(0, 1, 1), C0, 4); VRD2(1); \
      KRD(GL, 1); GAPB2(MFO(1, 1, 5), C0, 6); VRD2(5); \
      KRD(GL, 2); GAPB2(MFO(0, 2, 2), C0, 8); VRD2(2); \
      KRD(GL, 3); GAPB2(MFO(1, 2, 6), C0, 10); VRD2(6); \
      GAPB2(MFO(0, 3, 3), C0, 12); VRD2(3); \
      GAPB2(MFO(1, 3, 7), C0, 14); VRD2(7); \
      GAPB2(MFO(NDV - 2, 0, 0), C1, 0); \
      GAPB2(MFO(NDV - 1, 0, 4), C1, 2); \
      GAPB2(MFO(NDV - 2, 1, 1), C1, 4); \
      GAPB2(MFO(NDV - 1, 1, 5), C1, 6); \
      GAPB2(MFO(NDV - 2, 2, 2), C1, 8); \
      GAPB2(MFO(NDV - 1, 2, 6), C1, 10); \
      GAPB2(MFO(NDV - 2, 3, 3), C1, 12); \
      GAPB2(MFO(NDV - 1, 3, 7), C1, 14); \
    } \
    } while (0)
  int t = 1;
  for (; t + 5 < NT; t += 2) {
    STEP(pB0, pB1, pA0, pA1, t, true, true, true);     WAIT_STEADY(); ROT();
    STEP(pA0, pA1, pB0, pB1, t + 1, true, true, true); WAIT_STEADY(); ROT();
  }
  #define ENDW(tt) do { if ((tt) + 3 < NT) { WAIT_STEADY(); } else if ((tt) + 2 < NT) { WAIT_VONLY(); } else { WAIT_BAR(0); } } while (0)
  for (; t + 1 < NT; t += 2) {
    STEP(pB0, pB1, pA0, pA1, t, (t + 3 < NT), (t + 1 < NT), (t + 1 < NT));         ENDW(t);     ROT();
    STEP(pA0, pA1, pB0, pB1, t + 1, (t + 4 < NT), (t + 2 < NT), (t + 2 < NT));     ENDW(t + 1); ROT();
  }
  STEP(pB0, pB1, pA0, pA1, NT - 1, false, false, false);
  { float sacc = pB0[0] + pB0[1]; _Pragma("unroll") for (int r = 2; r < 16; ++r) sacc += pB0[r]; _Pragma("unroll") for (int r = 0; r < 16; ++r) sacc += pB1[r]; l_reg += sacc;
    pw0 = (u32x4){PKW(pB0, 0), PKW(pB0, 2), PKW(pB0, 4), PKW(pB0, 6)}; pw1 = (u32x4){PKW(pB0, 8), PKW(pB0, 10), PKW(pB0, 12), PKW(pB0, 14)}; pw2 = (u32x4){PKW(pB1, 0), PKW(pB1, 2), PKW(pB1, 4), PKW(pB1, 6)}; pw3 = (u32x4){PKW(pB1, 8), PKW(pB1, 10), PKW(pB1, 12), PKW(pB1, 14)};
    SBAR(); pvn<NDV>(o, vb0 + i_cur * VSLOT, PAF(0), PAF(1), PAF(2), PAF(3)); }
  #undef PKW
  #undef PAF
  #undef VFR
  #undef PIN
  #undef GAPA
  #undef GAPB
  #undef GAPB2
  #undef EX
  #undef VRD
  #undef VRD2
  #undef KRD
  #undef MFO
  #undef STEP
  #undef ENDW
  { auto rr = __builtin_amdgcn_permlane32_swap(__float_as_uint(l_reg), __float_as_uint(l_reg), false, false); l_reg = __uint_as_float(rr[0]) + __uint_as_float(rr[1]); }
  if (hi == 0) wsf[32 + r32] = l_reg; asm volatile("s_waitcnt lgkmcnt(0)" ::: "memory");
  float rli[16];
  #pragma unroll
  for (int r = 0; r < 16; ++r) rli[r] = __builtin_amdgcn_rcpf(wsf[32 + crow(r, hi)]);
  bf16_t* Ow = Ou + (long)(wid * QBLK) * PO;
  { bf16_t* stg = (bf16_t*)(shm + L_OST) + wid * 2048;
    #pragma unroll
    for (int h = 0; h < NV; ++h) {
      #pragma unroll
      for (int r = 0; r < 16; ++r) { const int orow = crow(r, hi);
        #pragma unroll
        for (int d0 = 0; d0 < 2; ++d0) stg[orow * 64 + d0 * 32 + r32] = (bf16_t)f2bf(o[2 * h + d0][r] * rli[r]); }
      asm volatile("s_waitcnt lgkmcnt(0)" ::: "memory");
      #pragma unroll
      for (int i = 0; i < 4; ++i) { const int row = i * 8 + (lane >> 3), ch = lane & 7; const u32x4 v = *(const u32x4*)(stg + row * 64 + ch * 8); *(u32x4*)(Ow + (long)row * PO + h * 64 + ch * 8) = v; }
      asm volatile("s_waitcnt lgkmcnt(0)" ::: "memory"); } }
  asm volatile("s_waitcnt lgkmcnt(0)\n\ts_barrier" ::: "memory");
  #undef DMA_K
  #undef DMA_V
  #undef ROT
  #undef WAIT_STEADY
  #undef WAIT_VONLY
}
#undef SBAR
#undef WAIT_BAR
}

__device__ __forceinline__ void transpose_item(const float* W, int N, bf16_t* WT, int ldt, int row_off, int koff, LAS float* scr, int item, int lane) {
    const int nblk = N / 32, kb = item / nblk, nb = item % nblk, k0 = 64 * kb, n0 = 32 * nb;
#pragma unroll 8
    for (int i = 0; i < 32; ++i) { const int kk = 2 * i + (lane >> 5); scr[kk * 33 + (lane & 31)] = W[(size_t)(k0 + kk) * N + n0 + (lane & 31)]; }
    LDS_WAIT(); asm volatile("" ::: "memory");
    const int c = lane & 7;
#pragma unroll
    for (int j = 0; j < 4; ++j) { const int n = (lane >> 3) + 8 * j; const LAS float* s = scr + (8 * c) * 33 + n;
        u32x4 o; o.x = pk2(s[0 * 33], s[1 * 33]); o.y = pk2(s[2 * 33], s[3 * 33]); o.z = pk2(s[4 * 33], s[5 * 33]); o.w = pk2(s[6 * 33], s[7 * 33]);
        *(u32x4*)(WT + (size_t)(row_off + n0 + n) * ldt + koff + k0 + 8 * c) = o; }
    LDS_WAIT(); asm volatile("" ::: "memory");
}

#define XB_TMO      128
#define XB_XCNT(j)  (256  + 64 * (j))
#define XB_XSUB(j)  (1280 + 64 * (j))
#define XB_XGEN(j)  (2304 + 64 * (j))
#define XB_TOP      3328
#define XB_TOPGEN   3392
#define XCD_BAR_WORDS 3456
#define XB_SPIN_CAP (1u << 22)
__device__ __forceinline__ unsigned xb_ld(unsigned* p)              { return __hip_atomic_load(p, __ATOMIC_RELAXED, __HIP_MEMORY_SCOPE_AGENT); }
__device__ __forceinline__ unsigned xb_add(unsigned* p, unsigned v) { return __hip_atomic_fetch_add(p, v, __ATOMIC_RELAXED, __HIP_MEMORY_SCOPE_AGENT); }
__device__ __forceinline__ unsigned xb_xcc_id() { return (unsigned)__builtin_amdgcn_s_getreg((3 << 11) | 20) & 0xFu; }
#define XB_SPIN(cond, bar) do { unsigned _sp = 0; while (cond) { __builtin_amdgcn_s_sleep(1); \
    if ((++_sp & 255u) == 0u) { if (xb_ld(&(bar)[XB_TMO])) break; if (_sp > XB_SPIN_CAP) { atomicAdd(&(bar)[XB_TMO], 1u); break; } } } } while (0)
struct XcdBarrier { unsigned* bar; unsigned x; volatile LAS unsigned* st; };
__device__ __forceinline__ XcdBarrier xcd_barrier_post(unsigned* bar, volatile LAS unsigned* st) {
    XcdBarrier b; b.bar = bar; b.x = xb_xcc_id(); b.st = st;
    if (threadIdx.x == 0) (void)xb_add(&bar[XB_XCNT(b.x)], 1u);
    return b;
}
__device__ __forceinline__ void xcd_barrier_complete(unsigned* bar, unsigned x, unsigned& nloc, unsigned& nx) {
    const unsigned G = gridDim.x * gridDim.y * gridDim.z;
    unsigned sum, cnt, mine, sp = 0u;
    for (;;) {
        sum = 0u; cnt = 0u; mine = 0u;
#pragma unroll
        for (unsigned j = 0; j < 16; ++j) { const unsigned c = xb_ld(&bar[XB_XCNT(j)]); sum += c; cnt += (c > 0u) ? 1u : 0u; mine = (j == x) ? c : mine; }
        if (sum == G) break;
        __builtin_amdgcn_s_sleep(1);
        if ((++sp & 255u) == 0u) { if (xb_ld(&bar[XB_TMO])) break; if (sp > XB_SPIN_CAP) { atomicAdd(&bar[XB_TMO], 1u); break; } }
    }
    nloc = mine > 0u ? mine : 1u; nx = cnt > 0u ? cnt : 1u;
}
__device__ __forceinline__ void xcd_barrier(const XcdBarrier& b) {
    asm volatile("s_waitcnt vmcnt(0)" ::: "memory");
    __syncthreads();
    if (threadIdx.x == 0) {
        unsigned* bar = b.bar; unsigned bx_ = b.x;
        asm volatile("" : "+s"(bar), "+s"(bx_));
        __builtin_amdgcn_s_waitcnt(0);
        unsigned nloc = b.st[0], nx = b.st[1];
        if (nloc == 0u) { xcd_barrier_complete(bar, bx_, nloc, nx); b.st[0] = nloc; b.st[1] = nx; }
        const unsigned old = xb_add(&bar[XB_XSUB(bx_)], 1u);
        const unsigned gen = old / nloc;
        if (old + 1u == (gen + 1u) * nloc) {
            __builtin_amdgcn_fence(__ATOMIC_RELEASE, "agent");
            asm volatile("s_waitcnt vmcnt(0)" ::: "memory");
            const unsigned og = xb_add(&bar[XB_TOP], 1u);
            const unsigned tg = og / nx;
            if (og + 1u == (tg + 1u) * nx) xb_add(&bar[XB_TOPGEN], 1u);
            else XB_SPIN(xb_ld(&bar[XB_TOPGEN]) == tg, bar);
            __builtin_amdgcn_fence(__ATOMIC_ACQUIRE, "agent");
            xb_add(&bar[XB_XGEN(bx_)], 1u);
            asm volatile("s_waitcnt vmcnt(0)" ::: "memory");
        } else {
            XB_SPIN(xb_ld(&bar[XB_XGEN(bx_)]) == gen, bar);
            __builtin_amdgcn_fence(__ATOMIC_ACQUIRE, "agent");
            asm volatile("s_waitcnt vmcnt(0)" ::: "memory");
        }
    }
    __syncthreads();
}

__device__ __forceinline__ int ltperm(int n) { const int t = n >> 8, r = n & 255, half = t >> 5, idx = t & 31; return ((((idx >> 2) * 8) + (half ? 0 : 4) + (idx & 3)) << 8) | r; }
__device__ __forceinline__ int seq_of(int chunk, int lt) { return (chunk == 0) ? (lt >> 11) : (8 + 2 * (chunk - 1) + (lt >> 13)); }

#define NORM_PHASE(L_, C_) do { const int l = (L_), chunk = (C_); const size_t tb = (size_t)chunk * CH; if (PH & 1) { PHASE_PTRS(); CHUNK_PTRS(); bf16_t* HN = OB; \
    for (int lt = gw; lt < CH; lt += NGW) { \
        const int s = seq_of(chunk, lt); \
        const f32x4* xr = (const f32x4*)(xin + (size_t)lt * DM) + lane; \
        f32x4 v[4]; float ss = 0.f; \
        _Pragma("unroll") for (int j = 0; j < 4; ++j) { v[j] = xr[64 * j]; ss += (v[j].x * v[j].x + v[j].y * v[j].y) + (v[j].z * v[j].z + v[j].w * v[j].w); } \
        const float rstd = rsqrtf(wave_sum(ss) * (1.f / DM) + EPS); \
        u32x2* o8 = (u32x2*)(HN + (size_t)lt * DM) + lane; \
        _Pragma("unroll") for (int j = 0; j < 4; ++j) { const int c = 4 * lane + 256 * j; \
            const f32x4 gn = *(const f32x4*)(PIN(4) + l * DM + c), sh = *(const f32x4*)(modl + s * 3072 + c), scl = *(const f32x4*)(modl + s * 3072 + 1024 + c); \
            const f32x4 y = v[j] * rstd * gn * (scl + 1.0f) + sh; \
            u32x2 w; w.x = pk2(y.x, y.y); w.y = pk2(y.z, y.w); o8[64 * j] = w; } \
    } } } while (0)

__global__ void __launch_bounds__(512, 2) fwd_megakernel(Params p) {
    extern __shared__ __attribute__((aligned(16))) unsigned char lds[];
    cg::grid_group grid = cg::this_grid();
    const int G = gridDim.x, bx = blockIdx.x, NGW = G * 8;
    unsigned char* ws = p.ws;
#define PHASE_PTRS() unsigned char* wsl = opq(ws); const int tid = opq_tid(), lane = tid & 63, wave = __builtin_amdgcn_readfirstlane(tid >> 6), gw = bx * 8 + wave; (void)lane; (void)gw; \
    float* MOD = (float*)(wsl + WS_MOD); float* SC = (float*)(wsl + WS_SC); float* TAB = (float*)(wsl + WS_TAB); \
    bf16_t* WIN = (bf16_t*)(wsl + WS_WIN); bf16_t* WO = (bf16_t*)(wsl + WS_WO); bf16_t* WOUT = (bf16_t*)(wsl + WS_WOUT); \
    bf16_t* H = (bf16_t*)(wsl + WS_H); float* LA = (float*)(wsl + WS_LA); bf16_t* VAT = (bf16_t*)(wsl + WS_VAT); bf16_t* Y = (bf16_t*)(wsl + WS_VAT); \
    bf16_t* OB = (bf16_t*)(wsl + WS_OB); bf16_t* U = (bf16_t*)(wsl + WS_U); \
    (void)MOD; (void)SC; (void)TAB; (void)WIN; (void)WO; (void)WOUT; (void)H; (void)LA; (void)VAT; (void)Y; (void)OB; (void)U;
#define PIN(i) opq(p.in[i])
#define CHUNK_PTRS() const float* modl = MOD + (size_t)l * 12 * 3072; \
    const float* xin = (l == 0) ? ((chunk == 0) ? PIN(0) : PIN(1) + (tb - CH) * DM) : (opq(p.out) + tb * DM); \
    float* xout = opq(p.out) + tb * DM; (void)modl; (void)xin; (void)xout;
    LAS unsigned char* ldsl = (LAS unsigned char*)lds;
    if (threadIdx.x < 64) ((LAS unsigned*)(ldsl + RING_BYTES))[threadIdx.x] = 0u;
    __syncthreads();
    if (blockIdx.x == 0) for (int i = threadIdx.x; i < 4096; i += 512) ((unsigned*)(ws + WS_BAR))[i] = 0u;

    for (int rep = 0; rep < ((DUP & 1024) ? 2 : 1); ++rep) if (PH & 256) {
        PHASE_PTRS();
        LAS float* scr = (LAS float*)(ldsl + wave * 16384);
        constexpr int I_IN = 16 * 216, I_BG = 16 * 96, I_OA = 6 * 32, I_OB = 6 * 32, I_OC = 8 * 32, I_OUT = 16 * 32;
        constexpr int I_L = I_IN + I_BG + I_OA + I_OB + I_OC + I_OUT;
        for (int it = gw; it < 2 * I_L; it += NGW) {
            const int l = it / I_L; int r = it % I_L;
            if (r < I_IN) { transpose_item(PIN(7) + (size_t)l * 1024 * 6912, 6912, WIN + (size_t)l * NIN * 1024, 1024, 0, 0, scr, r, lane); continue; } r -= I_IN;
            if (r < I_BG) { transpose_item(PIN(22) + (size_t)l * 1024 * 3072, 3072, WIN + (size_t)l * NIN * 1024, 1024, 6912, 0, scr, r, lane); continue; } r -= I_BG;
            if (r < I_OA) { transpose_item(PIN(19) + (size_t)l * 384 * 1024, 1024, WO + (size_t)l * 1024 * LDY, LDY, 0, 0, scr, r, lane); continue; } r -= I_OA;
            if (r < I_OB) { transpose_item(PIN(20) + (size_t)l * 384 * 1024, 1024, WO + (size_t)l * 1024 * LDY, LDY, 0, 384, scr, r, lane); continue; } r -= I_OB;
            if (r < I_OC) { transpose_item(PIN(21) + (size_t)l * 512 * 1024, 1024, WO + (size_t)l * 1024 * LDY, LDY, 0, 768, scr, r, lane); continue; } r -= I_OC;
            transpose_item(PIN(24) + (size_t)l * 1024 * 1024, 1024, WOUT + (size_t)l * 1024 * 1024, 1024, 0, 0, scr, r, lane);
        }
        __syncthreads();
        {
            LAS float* sc = (LAS float*)ldsl;
            LAS float* part = (LAS float*)(ldsl + 49152);
            for (int item = bx; item < 96; item += G) {
                const int l = item / 48, cb = item % 48;
                for (int idx = lane; idx < 12 * 128; idx += 64) { const int s = idx >> 7, kk = idx & 127;
                    const float cv = (s < 8) ? PIN(2)[s * 1024 + 128 * wave + kk] : PIN(3)[(s - 8) * 1024 + 128 * wave + kk];
                    sc[(wave * 12 + s) * 128 + kk] = cv * sigmoidf_(cv); }
                LDS_WAIT(); asm volatile("" ::: "memory");
                float a[12];
#pragma unroll
                for (int s = 0; s < 12; ++s) a[s] = 0.f;
                const float* wp = PIN(5) + (size_t)l * 1024 * 3072 + (size_t)(128 * wave) * 3072 + cb * 64 + lane;
#pragma unroll 4
                for (int kk = 0; kk < 128; ++kk) { const float wv = wp[(size_t)kk * 3072];
#pragma unroll
                    for (int s = 0; s < 12; ++s) a[s] += sc[(wave * 12 + s) * 128 + kk] * wv; }
#pragma unroll
                for (int s = 0; s < 12; ++s) part[(wave * 12 + s) * 64 + lane] = a[s];
                __syncthreads();
                for (int o = tid; o < 768; o += 512) { const int s = o >> 6, ln = o & 63; float v = PIN(6)[l * 3072 + cb * 64 + ln];
#pragma unroll
                    for (int w = 0; w < 8; ++w) v += part[(w * 12 + s) * 64 + ln];
                    MOD[((size_t)l * 12 + s) * 3072 + cb * 64 + ln] = v; }
                __syncthreads();
            }
        }
        if (bx == 0 && wave == 0) {
            if (lane < 36) { double inv = 0.0;
#pragma unroll
                for (int i = 0; i < 36; ++i) inv = (lane == i) ? p.inv[i] : inv;
                const float h = __builtin_bit_cast(float, __builtin_bit_cast(unsigned, (float)inv) & 0xFFFFC000u);
                SC[16 + 2 * lane] = h; SC[16 + 2 * lane + 1] = (float)(inv - (double)h); }
            for (int l = 0; l < 2; ++l) {
                const float d1 = wave_sum(PIN(14)[l * 64 + lane] * PIN(15)[l * 64 + lane]);
                const float d2 = wave_sum(PIN(16)[l * 64 + lane] * PIN(17)[l * 64 + lane]);
                const float lam_init = (l == 0) ? 0.2f : 0.35550906759096926f;
                float mq = fmaxf(fabsf(PIN(8)[l * 96 + lane]), (lane < 32) ? fabsf(PIN(8)[l * 96 + 64 + lane]) : 0.f);
                float mk = fmaxf(fabsf(PIN(9)[l * 96 + lane]), (lane < 32) ? fabsf(PIN(9)[l * 96 + 64 + lane]) : 0.f);
                mq = wave_max(mq); mk = wave_max(mk);
                if (lane == 0) { SC[l] = __expf(d1) - __expf(d2) + lam_init; SC[2 + l] = -(9.797958971132712f * mq * mk * LOG2E + 0.5f); }
            }
        }
    }
    grid.sync();
    const XcdBarrier xbar = xcd_barrier_post((unsigned*)(ws + WS_BAR), (volatile LAS unsigned*)(ldsl + RING_BYTES + 32));
    NORM_PHASE(0, 0);
    GSYNC();

    for (int l = 0; l < 2; ++l) {
        const float lam_init = (l == 0) ? 0.2f : 0.35550906759096926f;
        for (int chunk = 0; chunk < NCHUNK; ++chunk) {
            const int SL = (chunk == 0) ? 2048 : 8192, SLsh = (chunk == 0) ? 11 : 13;
            const size_t tb = (size_t)chunk * CH;

            for (int rep = 0; rep < ((DUP & 2) ? 2 : 1); ++rep) if (PH & 2) {
                PHASE_PTRS(); CHUNK_PTRS();
                pg8::Gemm g{OB, WIN + (size_t)l * NIN * 1024, CH, NIN, 1024, 1024, 1024};
                pg8::StaticOrder S; S.init(CH, NIN, G, bx);
                pg8::EpiU E{U, PIN(23) + l * 3072};
                pg8::gemm_phase<pg8::EpiU, true>(ldsl, g, S, E);
            }
            GSYNC();

            if (PH & 4) {
                PHASE_PTRS(); CHUNK_PTRS();
                const float* qn_a = PIN(8) + l * 96; const float* kn_a = PIN(9) + l * 96;
                const float* qn_b = PIN(10) + l * 64; const float* kn_b = PIN(11) + l * 64;
                const float* qn_c = PIN(12) + l * 64; const float* kn_c = PIN(13) + l * 64;
                const int sub = lane >> 3, ll = lane & 7;
                const float* INVT = SC + 16;
                {
                    constexpr int NB = 4;
                    float gq[12], gk[12], ihi[12], ilo[12];
#pragma unroll
                    for (int e2 = 0; e2 < 12; ++e2) { gq[e2] = qn_a[12 * ll + e2]; gk[e2] = kn_a[12 * ll + e2]; ihi[e2] = INVT[2 * e2]; ilo[e2] = INVT[2 * e2 + 1]; }
                    const bool rot = ll < 2, first = ll == 0;
                    for (int it0 = gw; it0 < CH * 3; it0 += NGW * NB) {
                        u32x4 wa[NB]; u32x2 wb[NB];
#pragma unroll
                        for (int b = 0; b < NB; ++b) { const int it = min(it0 + b * NGW, CH * 3 - 1); const int lt = ltperm(it / 3), ha = (it % 3) * 8 + sub;
                            const bf16_t* up = U + (size_t)lt * LDU + 96 * ha + 12 * ll;
                            wa[b] = *(const GAS u32x4*)up; wb[b] = *(const GAS u32x2*)(up + 8); }
                        __builtin_amdgcn_sched_barrier(0);
#pragma unroll
                        for (int b = 0; b < NB; ++b) { const int it = it0 + b * NGW;
                            if (it < CH * 3) { const int lt = ltperm(it / 3), ha = (it % 3) * 8 + sub; const bool isq = ha < 12;
                                float x[12] = {bflo(wa[b].x), bfhi(wa[b].x), bflo(wa[b].y), bfhi(wa[b].y), bflo(wa[b].z), bfhi(wa[b].z), bflo(wa[b].w), bfhi(wa[b].w), bflo(wb[b].x), bfhi(wb[b].x), bflo(wb[b].y), bfhi(wb[b].y)};
                                float ss = 0.f;
#pragma unroll
                                for (int e2 = 0; e2 < 12; ++e2) ss += x[e2] * x[e2];
                                ss += shx<1>(ss); ss += shx<2>(ss); ss += shx<4>(ss);
                                const float rstd = rsqrtf(ss * (1.f / 96.f) + EPS);
                                const float scl = isq ? C2_96 : 1.0f;
                                const float fp = (float)(lt & (SL - 1));
#pragma unroll
                                for (int e2 = 0; e2 < 12; ++e2) { x[e2] = x[e2] * rstd * (isq ? gq[e2] : gk[e2]);
                                    const float pr = shx<1>(x[e2]);
                                    const float rev = __builtin_amdgcn_fractf(fp * ihi[e2]) + fp * ilo[e2];
                                    const float c1 = rot ? __builtin_amdgcn_cosf(rev) : 1.f, s1 = rot ? __builtin_amdgcn_sinf(rev) : 0.f;
                                    x[e2] = (x[e2] * c1 + (first ? -pr : pr) * s1) * scl; }
                                bf16_t* up = U + (size_t)lt * LDU + 96 * ha + 12 * ll;
                                u32x4 oa; oa.x = pk2(x[0], x[1]); oa.y = pk2(x[2], x[3]); oa.z = pk2(x[4], x[5]); oa.w = pk2(x[6], x[7]);
                                u32x2 ob; ob.x = pk2(x[8], x[9]); ob.y = pk2(x[10], x[11]);
                                *(GAS u32x4*)up = oa; *(GAS u32x2*)(up + 8) = ob; }
                            __builtin_amdgcn_sched_barrier(0); }
                    }
                }
                {
                    constexpr int NB = 8;
                    float g1[8], g3[8], bhi[8], blo[8], chi[8], clo[8];
#pragma unroll
                    for (int e2 = 0; e2 < 8; ++e2) { g1[e2] = kn_b[8 * ll + e2]; g3[e2] = kn_c[8 * ll + e2];
                        bhi[e2] = INVT[2 * (20 + 8 * (ll & 1) + e2)]; blo[e2] = INVT[2 * (20 + 8 * (ll & 1) + e2) + 1]; chi[e2] = INVT[2 * (12 + e2)]; clo[e2] = INVT[2 * (12 + e2) + 1]; }
                    for (int it0 = gw; it0 < CH * 2; it0 += NGW * NB) {
                        u32x4 wa[NB];
#pragma unroll
                        for (int b = 0; b < NB; ++b) { const int it = min(it0 + b * NGW, CH * 2 - 1); const int lt = ltperm(it >> 1), isBk = ((it & 1) == 0);
                            const bool active = !(isBk && sub < 6);
                            const int col = isBk ? (O_KB + 64 * ((sub < 6) ? 0 : (sub - 6))) : (O_KC + 64 * sub);
                            wa[b] = (u32x4){0u, 0u, 0u, 0u};
                            if (active) wa[b] = *(const GAS u32x4*)(U + (size_t)lt * LDU + col + 8 * ll); }
                        __builtin_amdgcn_sched_barrier(0);
#pragma unroll
                        for (int b = 0; b < NB; ++b) { const int it = it0 + b * NGW;
                            if (it < CH * 2) { const int lt = ltperm(it >> 1); const bool isB = ((it & 1) == 0);
                                const bool active = !(isB && sub < 6);
                                const int col = isB ? (O_KB + 64 * ((sub < 6) ? 0 : (sub - 6))) : (O_KC + 64 * sub);
                                float x[8] = {bflo(wa[b].x), bfhi(wa[b].x), bflo(wa[b].y), bfhi(wa[b].y), bflo(wa[b].z), bfhi(wa[b].z), bflo(wa[b].w), bfhi(wa[b].w)};
                                float ss = 0.f;
#pragma unroll
                                for (int e2 = 0; e2 < 8; ++e2) ss += x[e2] * x[e2];
                                ss += shx<1>(ss); ss += shx<2>(ss); ss += shx<4>(ss);
                                const float rstd = rsqrtf(ss * (1.f / 64.f) + EPS);
                                const int pos = lt & (SL - 1);
                                const float fp = (float)(isB ? ((ll < 4) ? (pos >> 6) : (pos & 63)) : pos);
                                const bool rot = isB ? true : (ll < 2);
                                const bool first = isB ? ((ll & 2) == 0) : (ll == 0);
#pragma unroll
                                for (int e2 = 0; e2 < 8; ++e2) { const float gsel = isB ? g1[e2] : g3[e2];
                                    x[e2] = x[e2] * rstd * gsel;
                                    const float p1 = shx<1>(x[e2]), p2 = shx<2>(x[e2]); const float pr = isB ? p2 : p1;
                                    const float rev = __builtin_amdgcn_fractf(fp * (isB ? bhi[e2] : chi[e2])) + fp * (isB ? blo[e2] : clo[e2]);
                                    const float c1 = rot ? __builtin_amdgcn_cosf(rev) : 1.f, s1 = rot ? __builtin_amdgcn_sinf(rev) : 0.f;
                                    x[e2] = x[e2] * c1 + (first ? -pr : pr) * s1; }
                                u32x4 oa; oa.x = pk2(x[0], x[1]); oa.y = pk2(x[2], x[3]); oa.z = pk2(x[4], x[5]); oa.w = pk2(x[6], x[7]);
                                if (active) *(GAS u32x4*)(U + (size_t)lt * LDU + col + 8 * ll) = oa; }
                            __builtin_amdgcn_sched_barrier(0); }
                    }
                }
                LAS bf16_t* scr = (LAS bf16_t*)(ldsl + wave * 13824);
                for (int rep = 0; rep < ((DUP & 512) ? 2 : 1); ++rep)
                for (int it = gw; it < 12 * 256; it += NGW) {
                    const int hv = it >> 8, blk = it & 255;
                    const int sl = (blk * 64) >> SLsh, p0 = (blk * 64) & (SL - 1);
                    const int dsh = 2 * (hv >> 2), Lsh = SLsh - dsh;
                    const size_t seqrow = (size_t)sl << SLsh;
#pragma unroll
                    for (int i2 = 0; i2 < 12; ++i2) { const int id = i2 * 64 + lane, pp = id / 12, ch = id % 12;
                        const int pcl = p0 + pp, c = pcl >> Lsh, i = pcl & ((1 << Lsh) - 1);
                        const u32x4 w = *(const u32x4*)(U + (seqrow + c + ((size_t)i << dsh)) * LDU + O_VA + 96 * hv + 8 * ch);
                        const int k15 = pp & 15, slot = (pp & ~15) | (k15 & 3) | ((k15 & 4) << 1) | ((k15 & 8) >> 1);
                        LAS bf16_t* d = scr + (8 * ch) * 72 + slot;
                        d[0 * 72] = (bf16_t)(w.x & 0xffff); d[1 * 72] = (bf16_t)(w.x >> 16); d[2 * 72] = (bf16_t)(w.y & 0xffff); d[3 * 72] = (bf16_t)(w.y >> 16);
                        d[4 * 72] = (bf16_t)(w.z & 0xffff); d[5 * 72] = (bf16_t)(w.z >> 16); d[6 * 72] = (bf16_t)(w.w & 0xffff); d[7 * 72] = (bf16_t)(w.w >> 16); }
                    LDS_WAIT(); asm volatile("" ::: "memory");
#pragma unroll
                    for (int i2 = 0; i2 < 12; ++i2) { const int id = i2 * 64 + lane, dv = id >> 3, pc = id & 7;
                        const u32x4 w = *(const LAS u32x4*)(scr + dv * 72 + 8 * pc);
                        const size_t blk32 = ((seqrow + p0) >> 5) + (pc >> 2); const int ks = (pc >> 1) & 1, hi2 = pc & 1;
                        *(GAS u32x4*)(VAT + ((((size_t)hv * (CH / 32) + blk32) * 2 + ks) * 3 + (dv >> 5)) * 512 + ((dv & 31) + 32 * hi2) * 8) = w; }
                    LDS_WAIT(); asm volatile("" ::: "memory");
                }
            }
            GSYNC();

            if (PH & 8) {
                PHASE_PTRS(); CHUNK_PTRS();
                const int nqb = SL >> 8, nseq = CH >> SLsh, NT = SL >> 6;
                const int nC = nseq * 8 * nqb, nB = nseq * 6 * nqb;
                const bool bal = (G == 256) && (nC == 512) && (nB == 384);
                const int lin = ((bx & 127) & 7) * 16 + ((bx & 127) >> 3);
                for (int rep = 0; rep < ((DUP & 8) ? 2 : 1); ++rep) if (PH & 128) {
                    const int cN = bal ? ((bx < 128) ? 3 : 1) : (nC - bx + G - 1) / G;
                    for (int i = 0; i < cN; ++i) {
                        const int un = bal ? ((bx < 128) ? (i * 128 + lin) : (384 + lin)) : (bx + i * G);
                        const int qb = un % nqb, r2 = un / nqb, sh = r2 & 7, sl = r2 >> 3;
                        const size_t seqrow = (size_t)sl << SLsh;
                        attn_body::attn_unit<4>(U + (seqrow + (size_t)qb * 256) * LDU + O_QC + 64 * sh, U + seqrow * LDU + O_KC + 64 * sh, U + seqrow * LDU + O_VC + 128 * (sh >> 1),
                                                OB + (seqrow + (size_t)qb * 256) * PO + 384 + 128 * sh, NT, (char*)lds, PIN(12) + l * 64, SC + 16, qb * 256);
                    }
                    const int bN = bal ? ((bx < 128) ? 0 : 3) : (nB - bx + G - 1) / G;
                    for (int i = 0; i < bN; ++i) {
                        const int un = bal ? (i * 128 + lin) : (bx + i * G);
                        const int qb = un % nqb, r2 = un / nqb, hu = r2 % 6, sl = r2 / 6;
                        const size_t seqrow = (size_t)sl << SLsh;
                        attn_body::attn_unit<2>(U + (seqrow + (size_t)qb * 256) * LDU + O_QB + 64 * hu, U + seqrow * LDU + O_KB + 64 * (hu / 3), U + seqrow * LDU + O_VB + 64 * (hu / 3),
                                                OB + (seqrow + (size_t)qb * 256) * PO + 64 * hu, NT, (char*)lds, PIN(10) + l * 64, SC + 16, qb * 256);
                    }
                }
                const float nb2 = SC[2 + l];
                const int r32 = lane & 31, hi = lane >> 5;
                const int per = SL >> 5;
                for (int rep = 0; rep < ((DUP & 4) ? 2 : 1); ++rep) {
                unsigned* actr = (unsigned*)(wsl + WS_BAR + 14336) + (rep * 6 + l * 3 + chunk) * 16;
                if (PH & 512) for (;;) {
                    volatile LAS int* slot = (volatile LAS int*)(ldsl + RING_BYTES + 64);
                    __syncthreads();
                    if (tid == 0) *slot = (int)__hip_atomic_fetch_add(actr, 1u, __ATOMIC_RELAXED, __HIP_MEMORY_SCOPE_AGENT);
                    __syncthreads();
                    const int bt = __builtin_amdgcn_readfirstlane(*slot);
                    if (bt * 8 >= (CH >> 5) * 12) break;
                    const int it = bt * 8 + wave;
                    const int ci = it % per; int rest = it / per;
                    const int j = rest & 3; rest >>= 2; const int g = rest % 3, sl = rest / 3;
                    const int dsh = 2 * g, Lsh = SLsh - dsh, L = 1 << Lsh, nbk = L >> 5;
                    const int c = ci / nbk, qb = ci % nbk, q0 = qb * 32, hv = g * 4 + j;
                    const size_t seqrow = (size_t)sl << SLsh;
                    const bf16_t* qp = U + (seqrow + c + ((size_t)(q0 + r32) << dsh)) * LDU + O_QA + hv * 96 + 8 * hi;
                    bf16x8 qr[6];
#pragma unroll
                    for (int d0 = 0; d0 < 6; ++d0) qr[d0] = *(const GAS bf16x8*)(qp + 16 * d0);
                    f32x16 o[3]; o[0] = f32x16{}; o[1] = f32x16{}; o[2] = f32x16{}; f32x16 ol = f32x16{};
                    const bf16x8 ones = {0x3F80, 0x3F80, 0x3F80, 0x3F80, 0x3F80, 0x3F80, 0x3F80, 0x3F80};
                    bf16x8 kf[2][6], vf[2][6];
#define A_LOAD(kb_, buf_) do { const int k0_ = q0 - 64 + 32 * (kb_); const int k0c_ = ((k0_ >= 0) && (k0_ < L)) ? k0_ : q0; \
                        const bf16_t* kp_ = U + (seqrow + c + ((size_t)(k0c_ + r32) << dsh)) * LDU + O_KA + hv * 96 + 8 * hi; \
                        const bf16_t* vp_ = VAT + (((size_t)hv * (CH / 32) + ((seqrow + ((size_t)c << Lsh) + k0c_) >> 5)) * 6) * 512 + lane * 8; \
                        _Pragma("unroll") for (int d0 = 0; d0 < 6; ++d0) kf[buf_][d0] = *(const GAS bf16x8*)(kp_ + 16 * d0); \
                        _Pragma("unroll") for (int ks = 0; ks < 2; ++ks) _Pragma("unroll") for (int dvb = 0; dvb < 3; ++dvb) vf[buf_][ks * 3 + dvb] = *(const GAS bf16x8*)(vp_ + (ks * 3 + dvb) * 512); } while (0)
                    A_LOAD(0, 0);
                    __builtin_amdgcn_sched_barrier(0);
#pragma unroll
                    for (int kb = 0; kb < 5; ++kb) {
                        if (kb < 4) { A_LOAD(kb + 1, (kb + 1) & 1); }
                        __builtin_amdgcn_sched_barrier(0);
                        const int k0 = q0 - 64 + 32 * kb; const bool inr = (k0 >= 0) && (k0 < L);
                        f32x16 s = f32x16{};
#pragma unroll
                        for (int d0 = 0; d0 < 6; ++d0) s = __builtin_amdgcn_mfma_f32_32x32x16_bf16(kf[kb & 1][d0], qr[d0], s, 0, 0, 0);
                        float pe[16];
#pragma unroll
                        for (int r = 0; r < 16; ++r) { const int kk = attn_body::crow(r, hi); bool valid = inr;
                            if (kb == 0) valid = valid && (kk >= r32);
                            if (kb == 4) valid = valid && (kk <= r32);
                            pe[r] = valid ? __builtin_amdgcn_exp2f(s[r] + nb2) : 0.f; }
#pragma unroll
                        for (int ks = 0; ks < 2; ++ks) {
                            u32x4 pw; pw.x = attn_body::cvtpk_s(pe[8 * ks + 0], pe[8 * ks + 1]); pw.y = attn_body::cvtpk_s(pe[8 * ks + 2], pe[8 * ks + 3]); pw.z = attn_body::cvtpk_s(pe[8 * ks + 4], pe[8 * ks + 5]); pw.w = attn_body::cvtpk_s(pe[8 * ks + 6], pe[8 * ks + 7]);
                            const bf16x8 pa = __builtin_bit_cast(bf16x8, pw);
#pragma unroll
                            for (int dvb = 0; dvb < 3; ++dvb) o[dvb] = __builtin_amdgcn_mfma_f32_32x32x16_bf16(pa, vf[kb & 1][ks * 3 + dvb], o[dvb], 0, 0, 0);
                            ol = __builtin_amdgcn_mfma_f32_32x32x16_bf16(pa, ones, ol, 0, 0, 0);
                        }
                        __builtin_amdgcn_sched_barrier(0);
                    }
#undef A_LOAD
                    {
                        int ln = lane; asm volatile("" : "+v"(ln));
                        const int r32s = ln & 31, his = ln >> 5;
                        LAS bf16_t* stg = (LAS bf16_t*)(ldsl + wave * 6400); LAS float* stl = (LAS float*)(ldsl + wave * 6400 + 6144);
#pragma unroll
                        for (int r = 0; r < 16; ++r) { const int orow = attn_body::crow(r, his);
                            stg[orow * 96 + r32s] = (bf16_t)f2bf(o[0][r]); stg[orow * 96 + 32 + r32s] = (bf16_t)f2bf(o[1][r]); stg[orow * 96 + 64 + r32s] = (bf16_t)f2bf(o[2][r]);
                            if (r32s == 0) stl[orow] = ol[r]; }
                        LDS_WAIT(); asm volatile("" ::: "memory");
#pragma unroll
                        for (int i2 = 0; i2 < 6; ++i2) { const int id = i2 * 64 + ln, row = id / 12, pc = id % 12;
                            const u32x4 w = *(const LAS u32x4*)(stg + id * 8);
                            const size_t trow = seqrow + c + ((size_t)(q0 + row) << dsh);
                            *(GAS u32x4*)(U + trow * LDU + O_VA + hv * 96 + 8 * pc) = w; }
                        if (ln < 32) { const size_t trow = seqrow + c + ((size_t)(q0 + ln) << dsh); *(GAS float*)(LA + trow * 12 + hv) = stl[ln]; }
                        LDS_WAIT(); asm volatile("" ::: "memory");
                    }
                }
                }
            }
            GSYNC();

            for (int rep = 0; rep < ((DUP & 16) ? 2 : 1); ++rep) if (PH & 16) {
                PHASE_PTRS(); CHUNK_PTRS();
                const float lam = SC[l];
                const float* subln = PIN(18) + l * 128;
                constexpr int NBP = 4;
                const int jA = lane >> 4, ddA = (lane & 15) * 6, idxB = lane * 6, hcC = lane >> 4, e0C = (lane & 15) * 8, vhC = e0C >> 6, ddC = e0C & 63;
                const f32x4 s0 = *(const f32x4*)(subln + e0C), s1 = *(const f32x4*)(subln + e0C + 4);
                for (int lt0 = gw; lt0 < CH; lt0 += NGW * NBP) {
                    unsigned qa[NBP][3][3], za[NBP][3], ob_[NBP][3], zb[NBP][3]; float la[NBP][3]; u32x4 ca[NBP], cb[NBP], zc[NBP];
#pragma unroll
                    for (int b = 0; b < NBP; ++b) { const int lt = min(lt0 + b * NGW, CH - 1);
                        const bf16_t* ur = U + (size_t)lt * LDU; const bf16_t* ob = OB + (size_t)lt * PO;
#pragma unroll
                        for (int g = 0; g < 3; ++g) { const GAS unsigned* q = (const GAS unsigned*)(ur + O_VA + (g * 4 + jA) * 96 + ddA); qa[b][g][0] = q[0]; qa[b][g][1] = q[1]; qa[b][g][2] = q[2];
                            la[b][g] = *(const GAS float*)(LA + (size_t)lt * 12 + g * 4 + jA); }
                        { const GAS unsigned* zq = (const GAS unsigned*)(ur + O_ZA + jA * 96 + ddA); za[b][0] = zq[0]; za[b][1] = zq[1]; za[b][2] = zq[2]; }
                        { const GAS unsigned* oq = (const GAS unsigned*)(ob + idxB); const GAS unsigned* zq = (const GAS unsigned*)(ur + O_ZB + idxB);
                          ob_[b][0] = oq[0]; ob_[b][1] = oq[1]; ob_[b][2] = oq[2]; zb[b][0] = zq[0]; zb[b][1] = zq[1]; zb[b][2] = zq[2]; }
                        ca[b] = *(const GAS u32x4*)(ob + 384 + ((2 * hcC) * 2 + vhC) * 64 + ddC); cb[b] = *(const GAS u32x4*)(ob + 384 + ((2 * hcC + 1) * 2 + vhC) * 64 + ddC);
                        zc[b] = *(const GAS u32x4*)(ur + O_ZC + hcC * 128 + e0C); }
                    __builtin_amdgcn_sched_barrier(0);
#pragma unroll
                    for (int b = 0; b < NBP; ++b) { const int lt = lt0 + b * NGW;
                        if (lt < CH) { bf16_t* y = Y + (size_t)lt * LDY;
                            {
                                float num[6] = {0.f, 0.f, 0.f, 0.f, 0.f, 0.f}; float den = 0.f;
#pragma unroll
                                for (int g = 0; g < 3; ++g) { num[0] += bflo(qa[b][g][0]); num[1] += bfhi(qa[b][g][0]); num[2] += bflo(qa[b][g][1]); num[3] += bfhi(qa[b][g][1]); num[4] += bflo(qa[b][g][2]); num[5] += bfhi(qa[b][g][2]); den += la[b][g]; }
                                const float rd = 1.0f / den; GAS unsigned* yo = (GAS unsigned*)(y + jA * 96 + ddA);
                                yo[0] = pk2(num[0] * rd * bflo(za[b][0]), num[1] * rd * bfhi(za[b][0])); yo[1] = pk2(num[2] * rd * bflo(za[b][1]), num[3] * rd * bfhi(za[b][1])); yo[2] = pk2(num[4] * rd * bflo(za[b][2]), num[5] * rd * bfhi(za[b][2])); }
                            {
                                GAS unsigned* yo = (GAS unsigned*)(y + 384 + idxB);
#pragma unroll
                                for (int e2 = 0; e2 < 3; ++e2) yo[e2] = pk2(bflo(ob_[b][e2]) * bflo(zb[b][e2]), bfhi(ob_[b][e2]) * bfhi(zb[b][e2])); }
                            {
                                const u32x4 a = ca[b], c2 = cb[b], z = zc[b];
                                float d[8] = {bflo(a.x) - lam * bflo(c2.x), bfhi(a.x) - lam * bfhi(c2.x), bflo(a.y) - lam * bflo(c2.y), bfhi(a.y) - lam * bfhi(c2.y),
                                              bflo(a.z) - lam * bflo(c2.z), bfhi(a.z) - lam * bfhi(c2.z), bflo(a.w) - lam * bflo(c2.w), bfhi(a.w) - lam * bfhi(c2.w)};
                                float ss = 0.f;
#pragma unroll
                                for (int e2 = 0; e2 < 8; ++e2) ss += d[e2] * d[e2];
                                const float rstd = rsqrtf(sum16(ss) * (1.f / 128.f) + EPS) * (1.0f - lam_init);
                                u32x4 w;
                                w.x = pk2(d[0] * rstd * s0.x * bflo(z.x), d[1] * rstd * s0.y * bfhi(z.x)); w.y = pk2(d[2] * rstd * s0.z * bflo(z.y), d[3] * rstd * s0.w * bfhi(z.y));
                                w.z = pk2(d[4] * rstd * s1.x * bflo(z.z), d[5] * rstd * s1.y * bfhi(z.z)); w.w = pk2(d[6] * rstd * s1.z * bflo(z.w), d[7] * rstd * s1.w * bfhi(z.w));
                                *(GAS u32x4*)(y + 768 + hcC * 128 + e0C) = w; }
                        }
                        __builtin_amdgcn_sched_barrier(0); }
                }
            }
            GSYNC();

            for (int rep = 0; rep < ((DUP & 32) ? 2 : 1); ++rep) if (PH & 32) {
                PHASE_PTRS(); CHUNK_PTRS();
                bf16_t* MG = H;
                const bf16_t* wo = WO + (size_t)l * 1024 * LDY;
                pg8::StaticOrder S; S.init(CH, DM, G, bx);
                { pg8::Gemm g{Y, wo, CH, DM, 384, LDY, LDY}; pg8::EpiMerge E{(const unsigned char*)(U + O_G), MG, 0}; pg8::gemm_phase<pg8::EpiMerge, true>(ldsl, g, S, E); }
                __syncthreads();
                { pg8::Gemm g{Y + 384, wo + 384, CH, DM, 384, LDY, LDY}; pg8::EpiMerge E{(const unsigned char*)(U + O_G) + 1024, MG, 1}; pg8::gemm_phase<pg8::EpiMerge, true>(ldsl, g, S, E); }
                __syncthreads();
                { pg8::Gemm g{Y + 768, wo + 768, CH, DM, 512, LDY, LDY}; pg8::EpiMerge E{(const unsigned char*)(U + O_G) + 2048, MG, 1}; pg8::gemm_phase<pg8::EpiMerge, true>(ldsl, g, S, E); }
            }
            GSYNC();

            for (int rep = 0; rep < (((DUP & 64) && l == 0) ? 2 : 1); ++rep) if (PH & 64) {
                PHASE_PTRS(); CHUNK_PTRS();
                pg8::Gemm g{H, WOUT + (size_t)l * 1024 * 1024, CH, DM, 1024, 1024, 1024};
                pg8::StaticOrder S; S.init(CH, DM, G, bx);
                pg8::EpiOut E{xin, xout, modl, chunk};
                pg8::gemm_phase<pg8::EpiOut, true>(ldsl, g, S, E);
            }
            if (!(l == 1 && chunk == NCHUNK - 1)) { const int nl = (chunk == NCHUNK - 1) ? l + 1 : l, nc = (chunk == NCHUNK - 1) ? 0 : chunk + 1; NORM_PHASE(nl, nc); }
            GSYNC();
        }
    }
}

extern "C" void kernel_launch(void* const* d_in, const int* in_sizes, int n_in, void* d_out, int out_size, void* d_ws, size_t ws_size, hipStream_t stream) {
    static int grid = 0;
    if (grid == 0) {
        if (n_in != 25 || ws_size < WS_END) { fprintf(stderr, "kernel_launch: unexpected n_in %d / ws %zu\n", n_in, ws_size); grid = -1; return; }
        int dev = 0, cus = 0, per_cu = 0;
        hipGetDevice(&dev); hipDeviceGetAttribute(&cus, hipDeviceAttributeMultiprocessorCount, dev);
        hipFuncSetAttribute((const void*)fwd_megakernel, hipFuncAttributeMaxDynamicSharedMemorySize, LDS_BYTES);
        hipOccupancyMaxActiveBlocksPerMultiprocessor(&per_cu, (const void*)fwd_megakernel, 512, LDS_BYTES);
        if (per_cu < 1) { fprintf(stderr, "kernel_launch: occupancy query says %d blocks per CU\n", per_cu); per_cu = 1; }
        grid = cus * 1;
        (void)hipGetLastError();
    }
    if (grid < 0) return;
    Params p{};
    for (int i = 0; i < 25; ++i) p.in[i] = (const float*)d_in[i];
    p.out = (float*)d_out; p.ws = (unsigned char*)d_ws;
    const double TWO_PI = 6.283185307179586476925286766559;
    for (int i = 0; i < 12; ++i) p.inv[i] = std::pow(500000.0, -(double)i / 12.0) / TWO_PI;
    for (int i = 0; i < 8; ++i) p.inv[12 + i] = std::pow(500000.0, -(double)i / 8.0) / TWO_PI;
    for (int i = 0; i < 16; ++i) p.inv[20 + i] = std::pow(10000.0, -(double)i / 16.0) / TWO_PI;
    void* args[] = {&p};
    hipError_t e = hipLaunchCooperativeKernel((const void*)fwd_megakernel, dim3(grid), dim3(512), args, LDS_BYTES, stream);
    if (e != hipSuccess) fprintf(stderr, "cooperative launch failed: %s (grid %d)\n", hipGetErrorString(e), grid);
}
```
